# Optimizing an MI355X kernel written in HIP

```python
import math
import jax, jax.numpy as jnp
from jax import lax
import numpy as np

D_MODEL = 1024
BATCH = 8
SEQ = 8192
DEPTH = 4
DEC_BATCH = 32
DEC_SEQ = 64
PAST_LEN = 2048

CHUNK = 64
HEAD_DIM = 64
A_HEADS = 4
A_BAND_CHUNKS = 8
A_REL_MAX = 128
A_REL_SIZE = (CHUNK - 1) + A_REL_MAX + 1
MLA_HEADS = 4
MLA_Q_RANK = 256
MLA_KV_RANK = 256
MLA_NOPE = 128
MLA_ROPE = 64
MLA_V = 128
SB_HEADS = 4
Q_BLOCK = 128
K_BLOCK = 128
Q_GROUPS = 8
BIG_POS = 2 ** 30
D_FF = 4 * D_MODEL
ROPE_THETA = 10000.0
EPS = 1e-6
NEG = -1e30
A_W = A_HEADS * HEAD_DIM
MLA_W = MLA_HEADS * MLA_V
SB_W = SB_HEADS * HEAD_DIM
MIX_W = A_W + MLA_W + SB_W
IN_COLS = 3 * A_W + MLA_Q_RANK + MLA_KV_RANK + MLA_ROPE + 3 * SB_W

kernel_name = "hybrid_chunkband_mla_stickbreak_stream_step"


def rmsnorm(x, g):
    xf = x.astype(jnp.float32)
    y = xf * lax.rsqrt(jnp.mean(xf * xf, axis=-1, keepdims=True) + EPS)
    return (y * g.astype(jnp.float32)).astype(x.dtype)


def rope(x, pos):
    half = x.shape[-1] // 2
    inv = ROPE_THETA ** (-jnp.arange(half, dtype=jnp.float32) / half)
    ang = pos.astype(jnp.float32)[:, None] * inv[None, :]
    shape = (1, pos.shape[0]) + (1,) * (x.ndim - 3) + (half,)
    cos, sin = jnp.cos(ang).reshape(shape), jnp.sin(ang).reshape(shape)
    x1, x2 = x[..., :half], x[..., half:]
    return jnp.concatenate([x1 * cos - x2 * sin, x1 * sin + x2 * cos], axis=-1).astype(x.dtype)


def _split_proj(h, pos, w_in, g_cq, g_ckv):
    B, S, _ = h.shape
    sizes = [A_W, A_W, A_W, MLA_Q_RANK, MLA_KV_RANK, MLA_ROPE, SB_W, SB_W, SB_W]
    cuts = [int(c) for c in np.cumsum(sizes)[:-1]]
    p = jnp.einsum('bsd,de->bse', h, w_in)
    qa, ka, va, cq, ckv, kr, qc, kc, vc = jnp.split(p, cuts, axis=-1)
    hd = lambda t: t.reshape(B, S, -1, HEAD_DIM)
    return (hd(qa), hd(ka), hd(va), rmsnorm(cq, g_cq), rmsnorm(ckv, g_ckv), rope(kr, pos),
            hd(qc), hd(kc), hd(vc))


def _rel_bias(rel, dist):
    idx = jnp.clip(dist, -(CHUNK - 1), A_REL_MAX) + (CHUNK - 1)
    return rel[:, idx].astype(jnp.float32)


def _band_prompt(q, k, v, rel):
    B, S, H, d = q.shape
    nc = S // CHUNK
    nb = A_BAND_CHUNKS + 1
    blk = lambda t: t.reshape(B, nc, CHUNK, H, d)

    def band(t):
        tp = jnp.pad(blk(t), ((0, 0), (A_BAND_CHUNKS, 0), (0, 0), (0, 0), (0, 0)))
        return jnp.concatenate([tp[:, i:i + nc] for i in range(nb)], axis=2)

    kb, vb = band(k), band(v)
    kpos = jnp.arange(nb * CHUNK)
    dist = A_BAND_CHUNKS * CHUNK + jnp.arange(CHUNK)[:, None] - kpos[None, :]
    bias = _rel_bias(rel, dist)
    valid = (jnp.arange(nc)[:, None] + kpos[None, :] // CHUNK) >= A_BAND_CHUNKS
    s = jnp.einsum('bcqhd,bckhd->bchqk', blk(q), kb).astype(jnp.float32) * HEAD_DIM ** -0.5 + bias[None, None]
    s = jnp.where(valid[None, :, None, None, :], s, NEG)
    p = jax.nn.softmax(s, axis=-1).astype(v.dtype)
    return jnp.einsum('bchqk,bckhd->bcqhd', p, vb).reshape(B, S, H, d)


def _band_sample(q, k, v, rel, n_cached):
    T, K = q.shape[1], k.shape[1]
    dist = (n_cached + jnp.arange(T))[:, None] - jnp.arange(K)[None, :]
    s = jnp.einsum('bqhd,bkhd->bhqk', q, k).astype(jnp.float32) * HEAD_DIM ** -0.5 + _rel_bias(rel, dist)[None]
    p = jax.nn.softmax(s, axis=-1).astype(v.dtype)
    return jnp.einsum('bhqk,bkhd->bqhd', p, v)


def _mla_q(cq, pos, w_uq):
    q = jnp.einsum('bsr,rhe->bshe', cq, w_uq)
    return q[..., :MLA_NOPE], rope(q[..., MLA_NOPE:], pos)


def _mla_kv(ckv, w_ukv):
    kv = jnp.einsum('bsr,rhe->bshe', ckv, w_ukv)
    return kv[..., :MLA_NOPE], kv[..., MLA_NOPE:]


def _mla_core(qn, qp, qpos, kn, kp, v, kpos):
    s = (jnp.einsum('bqhe,bkhe->bhqk', qn, kn).astype(jnp.float32)
         + jnp.einsum('bqhr,bkr->bhqk', qp, kp).astype(jnp.float32)) * (MLA_NOPE + MLA_ROPE) ** -0.5
    vis = (kpos[None, :] // CHUNK) <= (qpos[:, None] // CHUNK)
    s = jnp.where(vis, s, NEG)
    p = jax.nn.softmax(s, axis=-1).astype(v.dtype)
    return jnp.einsum('bhqk,bkhe->bqhe', p, v)


def _sb_core(q, qpos, k, v, kpos):
    B, K, H, d = k.shape
    pad = (-K) % K_BLOCK
    k = jnp.pad(k, ((0, 0), (0, pad), (0, 0), (0, 0)))
    v = jnp.pad(v, ((0, 0), (0, pad), (0, 0), (0, 0)))
    kpos = jnp.pad(kpos, (0, pad), constant_values=BIG_POS)
    nk = (K + pad) // K_BLOCK
    kb = k.reshape(B, nk, K_BLOCK, H, d)
    vb = v.reshape(B, nk, K_BLOCK, H, d)
    z = jnp.einsum('bqhd,bnjhd->bhqnj', q, kb).astype(jnp.float32) * HEAD_DIM ** -0.5
    causal = kpos.reshape(nk, K_BLOCK)[None] < qpos[:, None, None]
    l = jnp.where(causal, jax.nn.log_sigmoid(-z), 0.0)
    idx = jnp.arange(K_BLOCK)
    tri = (idx[:, None] >= idx[None, :]).astype(jnp.float32)
    inner = jnp.einsum('bhqnj,jk->bhqnk', l, tri)
    bidx = jnp.arange(nk)
    later = jnp.einsum('bhqm,mn->bhqn', inner[..., 0],
                       (bidx[:, None] > bidx[None, :]).astype(jnp.float32))
    a = jnp.where(causal, jnp.exp(jnp.minimum(z + inner + later[..., None], 0.0)), 0.0)
    return jnp.einsum('bhqnj,bnjhd->bqhd', a.astype(v.dtype), vb)


def _causal_sweep(core, qs, qpos, kvs, kpos):
    S = qpos.shape[0]
    nb = S // Q_BLOCK
    ng = min(Q_GROUPS, nb)
    bounds = [(i * nb) // ng for i in range(ng + 1)]
    outs = []
    for g0, g1 in zip(bounds[:-1], bounds[1:]):
        q0, q1, n = g0 * Q_BLOCK, g1 * Q_BLOCK, g1 - g0
        ks = tuple(t[:, :q1] for t in kvs)
        kp = kpos[:q1]
        blk = lambda t: jnp.moveaxis(t[:, q0:q1].reshape((t.shape[0], n, Q_BLOCK) + t.shape[2:]), 1, 0)
        xs = tuple(blk(t) for t in qs) + (qpos[q0:q1].reshape(n, Q_BLOCK),)
        out = lax.map(lambda a: core(*a[:-1], a[-1], *ks, kp), xs)
        out = jnp.moveaxis(out, 0, 1)
        outs.append(out.reshape((out.shape[0], n * Q_BLOCK) + out.shape[3:]))
    return jnp.concatenate(outs, axis=1)


def _merge(oa, om, osb, g_oa, g_om, g_os, w_out):
    B, S = oa.shape[:2]
    cat = jnp.concatenate([rmsnorm(oa.reshape(B, S, A_W), g_oa),
                           rmsnorm(om.reshape(B, S, MLA_W), g_om),
                           rmsnorm(osb.reshape(B, S, SB_W), g_os)], axis=-1)
    return jnp.einsum('bse,ed->bsd', cat, w_out)


def _ffn(h, w_up, w_down):
    u = jax.nn.relu(jnp.einsum('bsd,df->bsf', h, w_up))
    return jnp.einsum('bsf,fd->bsd', u * u, w_down)


def _mix_prompt(h, pos, w_in, g_cq, g_ckv, w_uq, w_ukv, a_rel, g_oa, g_om, g_os, w_out):
    S = h.shape[1]
    qa, ka, va, cq, ckv, kr, qc, kc, vc = _split_proj(h, pos, w_in, g_cq, g_ckv)
    oa = _band_prompt(qa, ka, va, a_rel)
    qn, qp = _mla_q(cq, pos, w_uq)
    kn, vm = _mla_kv(ckv, w_ukv)
    om = _causal_sweep(_mla_core, (qn, qp), pos, (kn, kr, vm), pos)
    osb = _causal_sweep(_sb_core, (qc,), pos, (kc, vc), pos)
    y = _merge(oa, om, osb, g_oa, g_om, g_os, w_out)
    lc = min(A_BAND_CHUNKS * CHUNK, S)
    return y, (ka[:, -lc:], va[:, -lc:], ckv, kr, kc, vc)


def _mix_sample(h, c_ak, c_av, c_ckv, c_kr, c_sk, c_sv,
                w_in, g_cq, g_ckv, w_uq, w_ukv, a_rel, g_oa, g_om, g_os, w_out):
    T = h.shape[1]
    n_past = c_ckv.shape[1]
    n_band = c_ak.shape[1]
    pos = n_past + jnp.arange(T)
    kpos = jnp.arange(n_past + T)
    qa, ka, va, cq, ckv, kr, qc, kc, vc = _split_proj(h, pos, w_in, g_cq, g_ckv)
    k_band = jnp.concatenate([c_ak, ka], axis=1)
    v_band = jnp.concatenate([c_av, va], axis=1)
    oa = _band_sample(qa, k_band, v_band, a_rel, n_band)
    qn, qp = _mla_q(cq, pos, w_uq)
    kn, vm = _mla_kv(jnp.concatenate([c_ckv, ckv], axis=1), w_ukv)
    om = _mla_core(qn, qp, pos, kn, jnp.concatenate([c_kr, kr], axis=1), vm, kpos)
    osb = _sb_core(qc, pos, jnp.concatenate([c_sk, kc], axis=1), jnp.concatenate([c_sv, vc], axis=1), kpos)
    y = _merge(oa, om, osb, g_oa, g_om, g_os, w_out)
    return y, (k_band[:, -n_band:], v_band[:, -n_band:], ckv, kr, kc, vc)


def setup_inputs(seed: int = 0) -> dict:
    key = jax.random.key(seed)
    ks = jax.random.split(key, 26)
    f32 = jnp.float32
    nrm = lambda k, shape, scale: jax.random.normal(k, shape, f32) * scale
    gain = lambda k, shape: 1.0 + 0.02 * jax.random.normal(k, shape, f32)
    la = min(A_BAND_CHUNKS * CHUNK, PAST_LEN)
    return {
        "x_prompt": nrm(ks[0], (BATCH, SEQ, D_MODEL), 1.0),
        "x_sample": nrm(ks[1], (DEC_BATCH, DEC_SEQ, D_MODEL), 1.0),
        "cache_a_k": nrm(ks[2], (DEPTH, DEC_BATCH, la, A_HEADS, HEAD_DIM), 1.0),
        "cache_a_v": nrm(ks[3], (DEPTH, DEC_BATCH, la, A_HEADS, HEAD_DIM), 1.0),
        "cache_mla_ckv": nrm(ks[4], (DEPTH, DEC_BATCH, PAST_LEN, MLA_KV_RANK), 1.0),
        "cache_mla_krope": nrm(ks[5], (DEPTH, DEC_BATCH, PAST_LEN, MLA_ROPE), 1.0),
        "cache_sb_k": nrm(ks[6], (DEPTH, DEC_BATCH, PAST_LEN, SB_HEADS, HEAD_DIM), 1.0),
        "cache_sb_v": nrm(ks[7], (DEPTH, DEC_BATCH, PAST_LEN, SB_HEADS, HEAD_DIM), 1.0),
        "g_mix": gain(ks[8], (DEPTH, D_MODEL)),
        "w_in": nrm(ks[9], (DEPTH, D_MODEL, IN_COLS), D_MODEL ** -0.5),
        "g_cq": gain(ks[10], (DEPTH, MLA_Q_RANK)),
        "g_ckv": gain(ks[11], (DEPTH, MLA_KV_RANK)),
        "w_uq": nrm(ks[12], (DEPTH, MLA_Q_RANK, MLA_HEADS, MLA_NOPE + MLA_ROPE), MLA_Q_RANK ** -0.5),
        "w_ukv": nrm(ks[13], (DEPTH, MLA_KV_RANK, MLA_HEADS, MLA_NOPE + MLA_V), MLA_KV_RANK ** -0.5),
        "a_rel_bias": nrm(ks[14], (DEPTH, A_HEADS, A_REL_SIZE), 0.5),
        "g_out_a": gain(ks[15], (DEPTH, A_W)),
        "g_out_mla": gain(ks[16], (DEPTH, MLA_W)),
        "g_out_sb": gain(ks[17], (DEPTH, SB_W)),
        "w_out": nrm(ks[18], (DEPTH, MIX_W, D_MODEL), (2.0 * MIX_W) ** -0.5),
        "g_ffn": gain(ks[19], (DEPTH, D_MODEL)),
        "w_up": nrm(ks[20], (DEPTH, D_MODEL, D_FF), D_MODEL ** -0.5),
        "w_down": nrm(ks[21], (DEPTH, D_FF, D_MODEL), (2.0 * D_FF) ** -0.5),
        "g_final": gain(ks[22], (D_MODEL,)),
    }


def reference(x_prompt, x_sample, cache_a_k, cache_a_v, cache_mla_ckv, cache_mla_krope, cache_sb_k, cache_sb_v,
              g_mix, w_in, g_cq, g_ckv, w_uq, w_ukv, a_rel_bias, g_out_a, g_out_mla, g_out_sb, w_out,
              g_ffn, w_up, w_down, g_final):
    xp, xs = x_prompt, x_sample
    pos_p = jnp.arange(xp.shape[1])
    prompt_states, sample_states = [], []
    for l in range(DEPTH):
        lw = (w_in[l], g_cq[l], g_ckv[l], w_uq[l], w_ukv[l], a_rel_bias[l],
              g_out_a[l], g_out_mla[l], g_out_sb[l], w_out[l])
        yp, st_p = _mix_prompt(rmsnorm(xp, g_mix[l]), pos_p, *lw)
        ys, st_s = _mix_sample(rmsnorm(xs, g_mix[l]), cache_a_k[l], cache_a_v[l], cache_mla_ckv[l],
                               cache_mla_krope[l], cache_sb_k[l], cache_sb_v[l], *lw)
        xp = xp + yp
        xs = xs + ys
        xp = xp + _ffn(rmsnorm(xp, g_ffn[l]), w_up[l], w_down[l])
        xs = xs + _ffn(rmsnorm(xs, g_ffn[l]), w_up[l], w_down[l])
        prompt_states.append(st_p)
        sample_states.append(st_s)
    p_a_k, p_a_v, p_ckv, p_krope, p_sb_k, p_sb_v = [jnp.stack(t, axis=0) for t in zip(*prompt_states)]
    s_a_k, s_a_v, s_ckv, s_krope, s_sb_k, s_sb_v = [jnp.stack(t, axis=0) for t in zip(*sample_states)]
    y_prompt = rmsnorm(xp, g_final)
    y_sample = rmsnorm(xs, g_final)
    return (y_prompt, y_sample, p_a_k, p_a_v, p_ckv, p_krope, p_sb_k, p_sb_v,
            s_a_k, s_a_v, s_ckv, s_krope, s_sb_k, s_sb_v)
```

```cpp
#include <hip/hip_runtime.h>
#include <cstdio>
#include <cstdint>
namespace pg8 {
#define PG8_LAS __attribute__((address_space(3)))
typedef unsigned short bf16_t;
typedef short bf16x8 __attribute__((ext_vector_type(8)));
typedef float f32x4 __attribute__((ext_vector_type(4)));
typedef unsigned u32x4 __attribute__((ext_vector_type(4)));
constexpr int BM = 256, BK = 64, HALF = 128, HTB = HALF * BK * 2  , STAGE_BYTES = 8 * HTB, NXCD = 8, WGM = 8;

__host__ __device__ __forceinline__ int lds_byte(int r, int c) { const int st = (r >> 4) * 2 + (c >> 5), rr = r & 15, cc = c & 31, ob = rr * 64 + cc * 2; return st * 1024 + (ob ^ (((ob >> 9) & 1) << 5)); }
__host__ __device__ __forceinline__ void stage_rc(int b, int& R, int& C) { const int st = b / 1024, sb = b % 1024, swz = sb ^ (((sb >> 9) & 1) << 5); R = (st >> 1) * 16 + swz / 64; C = (st & 1) * 32 + (swz % 64) / 2; }
__host__ __device__ __forceinline__ int perm32(int rho) { const int n = rho >> 4, i = rho & 15; return 8 * (i >> 2) + 4 * n + (i & 3); }

struct Unit { int pm, pn; };
struct Gemm { const bf16_t* A; const bf16_t* Bt; int M, N, K; };

struct StaticOrder {
    int nM, nN, nwg, G, c;
    __host__ __device__ void init(int M, int N, int G_, int c_) { nM = M / BM; nN = N / BM; nwg = nM * nN; G = G_; c = c_; }
    __host__ __device__ bool next(int i, Unit& u) const {
        const long L = (long)i * G + c; if (L >= nwg) return false;
        int wgid = (int)L; { const int q = nwg / NXCD, r = nwg % NXCD, xcd = wgid % NXCD, off = wgid / NXCD; wgid = (xcd < r ? xcd * (q + 1) : r * (q + 1) + (xcd - r) * q) + off; }
        const int nig = WGM * nN, gid = wgid / nig, fm = gid * WGM, gsz = (nM - fm) < WGM ? (nM - fm) : WGM;
        u.pm = fm + ((wgid % nig) % gsz); u.pn = (wgid % nig) / gsz; return true;
    }
    __device__ __forceinline__ void a_ready(const Unit&) const {}
    __device__ __forceinline__ void done(const Unit&) const {}
};

__device__ __forceinline__ unsigned cvt_pk_bf16(float lo, float hi) { unsigned r; asm volatile("v_cvt_pk_bf16_f32 %0, %1, %2" : "=v"(r) : "v"(lo), "v"(hi)); return r; }
typedef float f32x2 __attribute__((ext_vector_type(2)));
template <class Epi, class Sched, bool ALIGN_EPI = false, bool SP2 = false>
__device__ __forceinline__ void gemm_phase(PG8_LAS unsigned char* lds, const Gemm g, const Sched& S, const Epi& E, const int wid_in  ) {
    int lane_; asm volatile("v_mbcnt_lo_u32_b32 %0, -1, 0\n\tv_mbcnt_hi_u32_b32 %0, -1, %0" : "=v"(lane_));
    const int wid = wid_in, lane = lane_, tid = wid * 64 + lane, wr = wid >> 2, wc = wid & 3, fr = lane & 15, fq = lane >> 4;
    const int K = g.K, nt = K / BK;
    unsigned voffA[2], voffB[2];
#pragma unroll
    for (int i = 0; i < 2; ++i) { int R, C; stage_rc(tid * 16 + i * 8192, R, C); const int Rb = Epi::PERM ? ((R & ~31) + perm32(R & 31)) : R;
        voffA[i] = (unsigned)(R * K + C) * 2u; voffB[i] = (unsigned)(Rb * K + C) * 2u; }
    const size_t kstep = (size_t)(BK * 2);
    const size_t hstep = (size_t)HALF * K * 2;
    const size_t tstep = 2 * hstep;
    const unsigned ldsw = (unsigned)wid * 1024u;
    const int aoff = lds_byte(wr * 64 + fr, fq * 8), boff = lds_byte(wc * 32 + fr, fq * 8);
#define PG8_SA(b, h) (((b) * 2 + (h)) * HTB)
#define PG8_SB(b, h) ((4 + (b) * 2 + (h)) * HTB)
#define PG8_STAGE(bufoff, gbase, voff) do { _Pragma("unroll") for (int _i = 0; _i < 2; ++_i) \
        __builtin_amdgcn_global_load_lds((const unsigned*)((const char*)(gbase) + (voff)[_i]), (PG8_LAS unsigned*)(lds + (bufoff) + ldsw + _i * 8192), 16, 0, 0); } while (0)
#define PG8_LDA(dst, b, h) do { _Pragma("unroll") for (int m = 0; m < 4; ++m) _Pragma("unroll") for (int k = 0; k < 2; ++k) dst[m][k] = *(const PG8_LAS bf16x8*)(lds + PG8_SA(b, h) + aoff + m * 2048 + k * 1024); } while (0)
#define PG8_LDB(dst, b, h) do { _Pragma("unroll") for (int n = 0; n < 2; ++n) _Pragma("unroll") for (int k = 0; k < 2; ++k) dst[n][k] = *(const PG8_LAS bf16x8*)(lds + PG8_SB(b, h) + boff + n * 2048 + k * 1024); } while (0)
#define PG8_MMA(ai, bj, At, Bt) do { __builtin_amdgcn_s_setprio(1); _Pragma("unroll") for (int m = 0; m < 4; ++m) _Pragma("unroll") for (int n = 0; n < 2; ++n) _Pragma("unroll") for (int k = 0; k < 2; ++k) \
        acc[ai][bj][m][n] = __builtin_amdgcn_mfma_f32_16x16x32_bf16(Bt[n][k], At[m][k], acc[ai][bj][m][n], 0, 0, 0); __builtin_amdgcn_s_setprio(0); } while (0)
#define PG8_WAIT_V(n) asm volatile("s_waitcnt vmcnt(" #n ")" ::: "memory")
#define PG8_WAIT_L(n) asm volatile("s_waitcnt lgkmcnt(" #n ")" ::: "memory")
#define PG8_BAR __builtin_amdgcn_s_barrier()
#define PG8_SCHED __builtin_amdgcn_sched_barrier(0)
    Unit cur, nxt; int ui = 0;
    if (!S.next(0, cur)) return;
    f32x4 acc[2][2][4][2];
#pragma unroll
    for (int a = 0; a < 2; ++a)
#pragma unroll
        for (int b = 0; b < 2; ++b)
#pragma unroll
            for (int m = 0; m < 4; ++m)
#pragma unroll
                for (int n = 0; n < 2; ++n) acc[a][b][m][n] = (f32x4){0.f, 0.f, 0.f, 0.f};
    bf16x8 At[4][2], B0[2][2], B1[2][2];
    const char* cA = (const char*)g.A + (size_t)cur.pm * tstep; const char* cB = (const char*)g.Bt + (size_t)cur.pn * tstep;
    S.a_ready(cur);
    if constexpr (SP2) {
        PG8_STAGE(PG8_SB(0, 0), cB, voffB); PG8_STAGE(PG8_SB(0, 1), cB + hstep, voffB); PG8_STAGE(PG8_SA(0, 0), cA, voffA); PG8_STAGE(PG8_SA(0, 1), cA + hstep, voffA);
        if (wr == 1) PG8_BAR;
        PG8_WAIT_V(2); PG8_BAR;
        PG8_STAGE(PG8_SB(1, 0), cB + kstep, voffB); PG8_STAGE(PG8_SA(1, 0), cA + kstep, voffA); PG8_STAGE(PG8_SB(1, 1), cB + hstep + kstep, voffB);
        PG8_WAIT_V(6); PG8_BAR;
    } else {
        PG8_STAGE(PG8_SB(0, 0), cB, voffB); PG8_STAGE(PG8_SA(0, 0), cA, voffA); PG8_STAGE(PG8_SB(0, 1), cB + hstep, voffB); PG8_STAGE(PG8_SA(0, 1), cA + hstep, voffA);
        if (wr == 1) PG8_BAR;
        PG8_WAIT_V(4); PG8_BAR;
        PG8_STAGE(PG8_SB(1, 0), cB + kstep, voffB); PG8_STAGE(PG8_SA(1, 0), cA + kstep, voffA); PG8_STAGE(PG8_SB(1, 1), cB + hstep + kstep, voffB);
        PG8_WAIT_V(6); PG8_BAR;
    }
    for (;;) {
        const bool has_next = S.next(ui + 1, nxt);
        const char* nA = has_next ? (const char*)g.A + (size_t)nxt.pm * tstep : cA; const char* nB = has_next ? (const char*)g.Bt + (size_t)nxt.pn * tstep : cB;
        for (int t = 0; t < nt; t += 2) {
            const bool last = (t == nt - 2);
            const char* a1 = cA + (size_t)(t + 1) * kstep;
            const char* a2 = last ? nA : cA + (size_t)(t + 2) * kstep; const char* b2 = last ? nB : cB + (size_t)(t + 2) * kstep;
            const char* a3 = a2 + kstep; const char* b3 = b2 + kstep;
            if (last && has_next) S.a_ready(nxt);
            if constexpr (SP2) {
            PG8_LDB(B0, 0, 0); PG8_LDB(B1, 0, 1); PG8_SCHED; PG8_LDA(At, 0, 0); PG8_STAGE(PG8_SA(1, 1), a1 + hstep, voffA);
            PG8_WAIT_V(8); PG8_WAIT_L(0); PG8_BAR; PG8_MMA(0, 0, At, B0); PG8_MMA(0, 1, At, B1); PG8_BAR; PG8_SCHED;
            PG8_LDA(At, 0, 1); PG8_STAGE(PG8_SB(0, 0), b2, voffB); PG8_STAGE(PG8_SB(0, 1), b2 + hstep, voffB); PG8_STAGE(PG8_SA(0, 0), a2, voffA);
            PG8_WAIT_V(8); PG8_WAIT_L(0); PG8_BAR; PG8_MMA(1, 0, At, B0); PG8_MMA(1, 1, At, B1); PG8_BAR; PG8_SCHED;
            PG8_LDB(B0, 1, 0); PG8_LDB(B1, 1, 1); PG8_SCHED; PG8_LDA(At, 1, 0); PG8_STAGE(PG8_SA(0, 1), a2 + hstep, voffA);
            PG8_WAIT_V(8); PG8_WAIT_L(0); PG8_BAR; PG8_MMA(0, 0, At, B0); PG8_MMA(0, 1, At, B1); PG8_BAR; PG8_SCHED;
            PG8_LDA(At, 1, 1); PG8_STAGE(PG8_SB(1, 0), b3, voffB); PG8_STAGE(PG8_SB(1, 1), b3 + hstep, voffB); PG8_STAGE(PG8_SA(1, 0), a3, voffA);
            PG8_WAIT_V(8); PG8_WAIT_L(0); PG8_BAR; PG8_MMA(1, 0, At, B0); PG8_MMA(1, 1, At, B1); PG8_BAR; PG8_SCHED;
            } else {
            PG8_LDB(B0, 0, 0); PG8_SCHED; PG8_LDA(At, 0, 0); PG8_STAGE(PG8_SA(1, 1), a1 + hstep, voffA);
            PG8_WAIT_L(8); PG8_BAR; PG8_WAIT_L(0); PG8_MMA(0, 0, At, B0); PG8_BAR; PG8_SCHED;
            PG8_LDB(B1, 0, 1); PG8_STAGE(PG8_SB(0, 0), b2, voffB);
            PG8_BAR; PG8_WAIT_L(0); PG8_MMA(0, 1, At, B1); PG8_BAR;
            PG8_LDA(At, 0, 1); PG8_STAGE(PG8_SA(0, 0), a2, voffA);
            PG8_BAR; PG8_WAIT_L(0); PG8_MMA(1, 0, At, B0); PG8_BAR; PG8_SCHED;
            PG8_STAGE(PG8_SB(0, 1), b2 + hstep, voffB);
            PG8_WAIT_V(6); PG8_BAR; PG8_MMA(1, 1, At, B1); PG8_BAR;
            PG8_LDB(B0, 1, 0); PG8_SCHED; PG8_LDA(At, 1, 0); PG8_STAGE(PG8_SA(0, 1), a2 + hstep, voffA);
            PG8_WAIT_L(8); PG8_BAR; PG8_WAIT_L(0); PG8_MMA(0, 0, At, B0); PG8_BAR; PG8_SCHED;
            PG8_LDB(B1, 1, 1); PG8_STAGE(PG8_SB(1, 0), b3, voffB);
            PG8_BAR; PG8_WAIT_L(0); PG8_MMA(0, 1, At, B1); PG8_BAR;
            PG8_LDA(At, 1, 1); PG8_STAGE(PG8_SA(1, 0), a3, voffA);
            PG8_BAR; PG8_WAIT_L(0); PG8_MMA(1, 0, At, B0); PG8_BAR; PG8_SCHED;
            PG8_STAGE(PG8_SB(1, 1), b3 + hstep, voffB);
            PG8_WAIT_V(6); PG8_BAR; PG8_MMA(1, 1, At, B1); PG8_BAR;
            }
        }
        if constexpr (ALIGN_EPI) { if (wr == 0) PG8_BAR; }
        if constexpr (!Epi::AFTER_DRAIN) { E(acc, cur, wr, wc, fr, fq); S.done(cur); }
        if (!has_next) break;
#pragma unroll
        for (int a = 0; a < 2; ++a)
#pragma unroll
            for (int b = 0; b < 2; ++b)
#pragma unroll
                for (int m = 0; m < 4; ++m)
#pragma unroll
                    for (int n = 0; n < 2; ++n) acc[a][b][m][n] = (f32x4){0.f, 0.f, 0.f, 0.f};
        cur = nxt; cA = nA; cB = nB; ++ui;
        if constexpr (ALIGN_EPI) { if (wr == 1) PG8_BAR; }
    }
    PG8_WAIT_V(0);
    if constexpr (!ALIGN_EPI) { if (wr == 0) PG8_BAR; }
    PG8_BAR;
    if constexpr (Epi::AFTER_DRAIN) { E.fused(acc, cur, wr, wc, fr, fq, lds, wid, lane); S.done(cur); }
#undef PG8_SA
#undef PG8_SB
#undef PG8_STAGE
#undef PG8_LDA
#undef PG8_LDB
#undef PG8_MMA
#undef PG8_WAIT_V
#undef PG8_WAIT_L
#undef PG8_BAR
#undef PG8_SCHED
}
}

#define LAS __attribute__((address_space(3)))
#define GAS __attribute__((address_space(1)))
typedef unsigned short bf16_t;
typedef short bf16x8 __attribute__((ext_vector_type(8)));
typedef short s16x4 __attribute__((ext_vector_type(4)));
typedef float f32x4 __attribute__((ext_vector_type(4)));
typedef float f32x16 __attribute__((ext_vector_type(16)));
typedef unsigned u32x4 __attribute__((ext_vector_type(4)));
typedef unsigned u32x2 __attribute__((ext_vector_type(2)));
typedef GAS unsigned gu32;

constexpr int DM = 1024, NBATCH = 8, SEQ = 8192, DEPTH = 4, DBATCH = 32, DSEQ = 64, PAST = 2048, LA = 512, DFF = 4096;
constexpr int TP = NBATCH * SEQ, TSAMP = DBATCH * DSEQ, T = TP + TSAMP;
constexpr int EA = T + DBATCH * LA, EC = T + DBATCH * PAST;
constexpr int NIN = 2304, INC = 2112;
constexpr float EPS = 1e-6f, LOG2E = 1.4426950408889634f, LN2 = 0.6931471805599453f;
constexpr int NWAVES = 8, NTHREADS = 512;

constexpr long OFF_Y = 0;
constexpr long OFF_PAK = (long)T * DM;
constexpr long SZ_PA = (long)DEPTH * NBATCH * LA * 256;
constexpr long OFF_PAV = OFF_PAK + SZ_PA;
constexpr long OFF_PCKV = OFF_PAV + SZ_PA;
constexpr long SZ_P256 = (long)DEPTH * TP * 256;
constexpr long OFF_PKR = OFF_PCKV + SZ_P256;
constexpr long OFF_PSBK = OFF_PKR + (long)DEPTH * TP * 64;
constexpr long OFF_PSBV = OFF_PSBK + SZ_P256;
constexpr long OFF_SAK = OFF_PSBV + SZ_P256;
constexpr long SZ_SA = (long)DEPTH * DBATCH * LA * 256;
constexpr long OFF_SAV = OFF_SAK + SZ_SA;
constexpr long OFF_SCKV = OFF_SAV + SZ_SA;
constexpr long SZ_S256 = (long)DEPTH * TSAMP * 256;
constexpr long OFF_SKR = OFF_SCKV + SZ_S256;
constexpr long OFF_SSBK = OFF_SKR + (long)DEPTH * TSAMP * 64;
constexpr long OFF_SSBV = OFF_SSBK + SZ_S256;
constexpr long OUT_TOTAL = OFF_SSBV + SZ_S256;
static_assert(OUT_TOTAL == 336068608L, "d_out map");

constexpr size_t WS_CTL = 0, CTL_BYTES = 1u << 20;
constexpr size_t WS_ROPE = WS_CTL + CTL_BYTES;
constexpr size_t WS_WIN = WS_ROPE + (size_t)8192 * 32 * 8;
constexpr size_t WS_WUQ = WS_WIN + (size_t)DEPTH * NIN * DM * 2;
constexpr size_t WS_WUKV = WS_WUQ + (size_t)DEPTH * 768 * 256 * 2;
constexpr size_t WS_WOUT = WS_WUKV + (size_t)DEPTH * 1024 * 256 * 2;
constexpr size_t WS_WUP = WS_WOUT + (size_t)DEPTH * DM * DM * 2;
constexpr size_t WS_WDN = WS_WUP + (size_t)DEPTH * DFF * DM * 2;
constexpr size_t WS_X = WS_WDN + (size_t)DEPTH * DFF * DM * 2;
constexpr size_t WS_SSQA = WS_X + (size_t)T * DM * 2;
constexpr size_t WS_SSQB = WS_SSQA + (size_t)T * 64;
constexpr size_t WS_ACT = WS_SSQB + (size_t)T * 64;
constexpr size_t WS_QA = WS_ACT;
constexpr size_t WS_KA = WS_QA + (size_t)T * 512;
constexpr size_t WS_VA = WS_KA + (size_t)EA * 512;
constexpr size_t WS_CQN = WS_VA + (size_t)EA * 512;
constexpr size_t WS_CKVN = WS_CQN + (size_t)T * 512;
constexpr size_t WS_KR = WS_CKVN + (size_t)EC * 512;
constexpr size_t WS_QC = WS_KR + (size_t)EC * 128;
constexpr size_t WS_KC = WS_QC + (size_t)T * 512;
constexpr size_t WS_VC = WS_KC + (size_t)EC * 512;
constexpr size_t WS_QM = WS_VC + (size_t)EC * 512;
constexpr size_t WS_KN = WS_QM + (size_t)T * 1536;
constexpr size_t WS_VM = WS_KN + (size_t)EC * 1024;
constexpr size_t WS_O = WS_VM + (size_t)EC * 1024;
constexpr size_t WS_ACT_END = WS_O + (size_t)T * DM * 2;
constexpr size_t WS_U = WS_ACT;
constexpr size_t WS_U_END = WS_U + (size_t)T * DFF * 2;
constexpr size_t WS_END = WS_ACT_END > WS_U_END ? WS_ACT_END : WS_U_END;
static_assert(WS_END < 1400000000ull, "d_ws map must stay below the guaranteed workspace size");
constexpr int CW_BAR = 4096;
constexpr int CW_QUEUE = 16384;

constexpr int LDS_XCH = 131072;
constexpr int LDS_MISC = LDS_XCH + 4096;
constexpr int LDS_BYTES = 147456;

__device__ __forceinline__ unsigned pk2(float lo, float hi) {
    typedef float f2_t __attribute__((ext_vector_type(2))); typedef __bf16 b2_t __attribute__((ext_vector_type(2)));
    f2_t v = {lo, hi}; b2_t b = __builtin_convertvector(v, b2_t); return __builtin_bit_cast(unsigned, b); }
__device__ __forceinline__ float bf_lo(unsigned w) { return __uint_as_float(w << 16); }
__device__ __forceinline__ float bf_hi(unsigned w) { return __uint_as_float(w & 0xffff0000u); }
__device__ __forceinline__ u32x2 pk4(f32x4 v) { u32x2 r; r.x = pk2(v.x, v.y); r.y = pk2(v.z, v.w); return r; }
__device__ __forceinline__ float sq4(f32x4 v) { return (v.x * v.x + v.y * v.y) + (v.z * v.z + v.w * v.w); }
#define LDS_WAIT() asm volatile("s_waitcnt lgkmcnt(0)" ::: "memory")
__device__ __forceinline__ int fresh_lane() { int l; asm volatile("v_mbcnt_lo_u32_b32 %0, -1, 0\n\tv_mbcnt_hi_u32_b32 %0, -1, %0" : "=v"(l)); return l; }
#define VM_WAIT() asm volatile("s_waitcnt vmcnt(0)" ::: "memory")

#define XB_TMO      128
#define XB_XCNT(j)  (256  + 64 * (j))
#define XB_XSUB(j)  (1280 + 64 * (j))
#define XB_XGEN(j)  (2304 + 64 * (j))
#define XB_TOP      3328
#define XB_TOPGEN   3392
#define XCD_BAR_WORDS 3456
#define XB_SPIN_CAP (1u << 22)
__device__ __forceinline__ unsigned xb_ld(unsigned* p)              { return __hip_atomic_load(p, __ATOMIC_RELAXED, __HIP_MEMORY_SCOPE_AGENT); }
__device__ __forceinline__ unsigned xb_add(unsigned* p, unsigned v) { return __hip_atomic_fetch_add(p, v, __ATOMIC_RELAXED, __HIP_MEMORY_SCOPE_AGENT); }
__device__ __forceinline__ unsigned xb_xcc_id() { return (unsigned)__builtin_amdgcn_s_getreg((3 << 11) | 20) & 0xFu; }
#define XB_SPIN(cond, bar) do { unsigned _sp = 0; while (cond) { __builtin_amdgcn_s_sleep(1); \
    if ((++_sp & 255u) == 0u) { if (xb_ld(&(bar)[XB_TMO])) break; if (_sp > XB_SPIN_CAP) { atomicAdd(&(bar)[XB_TMO], 1u); break; } } } } while (0)
struct XcdBarrier { unsigned* bar; unsigned x; volatile LAS unsigned* st; };
__device__ __forceinline__ XcdBarrier xcd_barrier_post(unsigned* bar, volatile LAS unsigned* st, bool thread0) {
    XcdBarrier b; b.bar = bar; b.x = xb_xcc_id(); b.st = st;
    if (thread0) (void)xb_add(&bar[XB_XCNT(b.x)], 1u);
    return b;
}
__device__ __forceinline__ void xcd_barrier_complete(unsigned* bar, unsigned x, unsigned& nloc, unsigned& nx) {
    const unsigned G = gridDim.x * gridDim.y * gridDim.z;
    unsigned sum, cnt, mine, sp = 0u;
    for (;;) {
        sum = 0u; cnt = 0u; mine = 0u;
#pragma unroll
        for (unsigned j = 0; j < 16; ++j) { const unsigned c = xb_ld(&bar[XB_XCNT(j)]); sum += c; cnt += (c > 0u) ? 1u : 0u; mine = (j == x) ? c : mine; }
        if (sum == G) break;
        __builtin_amdgcn_s_sleep(1);
        if ((++sp & 255u) == 0u) { if (xb_ld(&bar[XB_TMO])) break; if (sp > XB_SPIN_CAP) { atomicAdd(&bar[XB_TMO], 1u); break; } }
    }
    nloc = mine > 0u ? mine : 1u; nx = cnt > 0u ? cnt : 1u;
}
__device__ __forceinline__ void xcd_barrier(const XcdBarrier& b, bool thread0  ) {
    asm volatile("s_waitcnt vmcnt(0)" ::: "memory");
    __syncthreads();
    if (thread0) {
        unsigned* bar = b.bar;
        __builtin_amdgcn_s_waitcnt(0);
        unsigned nloc = b.st[0], nx = b.st[1];
        if (nloc == 0u) { xcd_barrier_complete(bar, b.x, nloc, nx); b.st[0] = nloc; b.st[1] = nx; }
        const unsigned old = xb_add(&bar[XB_XSUB(b.x)], 1u);
        const unsigned gen = old / nloc;
        if (old + 1u == (gen + 1u) * nloc) {
            __builtin_amdgcn_fence(__ATOMIC_RELEASE, "agent");
            asm volatile("s_waitcnt vmcnt(0)" ::: "memory");
            const unsigned og = xb_add(&bar[XB_TOP], 1u);
            const unsigned tg = og / nx;
            if (og + 1u == (tg + 1u) * nx) xb_add(&bar[XB_TOPGEN], 1u);
            else XB_SPIN(xb_ld(&bar[XB_TOPGEN]) == tg, bar);
            __builtin_amdgcn_fence(__ATOMIC_ACQUIRE, "agent");
            xb_add(&bar[XB_XGEN(b.x)], 1u);
            asm volatile("s_waitcnt vmcnt(0)" ::: "memory");
        } else {
            XB_SPIN(xb_ld(&bar[XB_XGEN(b.x)]) == gen, bar);
            __builtin_amdgcn_fence(__ATOMIC_ACQUIRE, "agent");
            asm volatile("s_waitcnt vmcnt(0)" ::: "memory");
        }
    }
    __syncthreads();
}

struct Args { const float* in[23]; float* out; unsigned char* ws; int ph_lo, ph_hi; };
struct Ctx {
    LAS unsigned char* lds;
    int tid, lane, wave, G, gw, ngw, bid;
    const Args* a;
    unsigned long long ws_, out_;
};
#define CIN(k) (C.a->in[k])
#define COUT ((float*)C.out_)
#define CWS ((unsigned char*)C.ws_)
#define WSP(T_, off) ((T_*)(CWS + (off)))

__device__ __forceinline__ float row_rs(const float* ssq, int row, int fq) {
    const f32x4 p = *(const f32x4*)(ssq + (size_t)row * 16 + 4 * fq);
    float s = (p.x + p.y) + (p.z + p.w);
    s += __shfl_xor(s, 16); s += __shfl_xor(s, 32);
    return rsqrtf(s * (1.0f / DM) + EPS);
}
__device__ __forceinline__ unsigned out_row_boff(int kind, int l, int r, bool& valid) {
    valid = true;
    if (r < TP) {
        const int b = r >> 13, t = r & (SEQ - 1);
        if (kind <= 1) { valid = t >= SEQ - LA; return (unsigned)((kind == 0 ? OFF_PAK : OFF_PAV) * 4) + (unsigned)((l * NBATCH + b) * LA + (t - (SEQ - LA))) * 1024u; }
        if (kind == 2) return (unsigned)(OFF_PCKV * 4) + (unsigned)(l * TP + r) * 1024u;
        if (kind == 3) return (unsigned)(OFF_PKR * 4) + (unsigned)(l * TP + r) * 256u;
        return (unsigned)((kind == 4 ? OFF_PSBK : OFF_PSBV) * 4) + (unsigned)(l * TP + r) * 1024u;
    } else {
        const int rs = r - TP, b = rs >> 6, t = rs & 63;
        if (kind <= 1) return (unsigned)((kind == 0 ? OFF_SAK : OFF_SAV) * 4) + (unsigned)((l * DBATCH + b) * LA + (LA - DSEQ) + t) * 1024u;
        if (kind == 2) return (unsigned)(OFF_SCKV * 4) + (unsigned)(l * TSAMP + rs) * 1024u;
        if (kind == 3) return (unsigned)(OFF_SKR * 4) + (unsigned)(l * TSAMP + rs) * 256u;
        return (unsigned)((kind == 4 ? OFF_SSBK : OFF_SSBV) * 4) + (unsigned)(l * TSAMP + rs) * 1024u;
    }
}
__device__ __forceinline__ int row_pos(int r) { return r < TP ? (r & (SEQ - 1)) : PAST + ((r - TP) & 63); }
static_assert(OUT_TOTAL * 4 < (1ll << 32) && WS_END < (1ull << 32), "32-bit byte offsets from the two base pointers");
#define ST8(base, boff, v)  (*(u32x2*)((char*)(base) + (boff)) = (v))
#define ST16F(base, boff, v) (*(f32x4*)((char*)(base) + (boff)) = (v))
#define LD16F(base, boff) (*(const f32x4*)((const char*)(base) + (boff)))


struct EpiIn {
    static constexpr bool PERM = false, AFTER_DRAIN = false;
    unsigned char* ws; float* out; int l; const float *g_cq, *g_ckv; LAS float* xch;
    __device__ __forceinline__ void operator()(const f32x4 (&acc)[2][2][4][2], const pg8::Unit& u, int wr, int wc, int fr, int fq) const {
        const int row0 = u.pm * 256 + wr * 64 + fr, t = u.pn, cl = wc * 32 + 4 * fq;
        float rs[2][4];
#pragma unroll
        for (int ai = 0; ai < 2; ++ai)
#pragma unroll
            for (int m = 0; m < 4; ++m) rs[ai][m] = row_rs((const float*)(ws + WS_SSQA), row0 + ai * 128 + m * 16, fq);
        if (t == 0 || t == 5) {
            const unsigned b0 = (unsigned)((t == 0) ? WS_QA : WS_QC) + (unsigned)(row0 * 256 + cl) * 2u;
#pragma unroll
            for (int ai = 0; ai < 2; ++ai)
#pragma unroll
                for (int m = 0; m < 4; ++m) { const unsigned ro = b0 + (unsigned)(ai * 128 + m * 16) * 512u; const float s = rs[ai][m];
#pragma unroll
                    for (int bj = 0; bj < 2; ++bj)
#pragma unroll
                        for (int n = 0; n < 2; ++n) ST8(ws, ro + bj * 256 + n * 32, pk4(acc[ai][bj][m][n] * s));
                    asm volatile("" ::: "memory"); }
        } else if (t == 1 || t == 2 || t == 6 || t == 7) {
            const unsigned b0 = (unsigned)((t == 1) ? WS_KA : (t == 2) ? WS_VA : (t == 6) ? WS_KC : WS_VC) + (unsigned)(row0 * 256 + cl) * 2u; const int kind = (t == 1) ? 0 : (t == 2) ? 1 : (t == 6) ? 4 : 5;
#pragma unroll
            for (int ai = 0; ai < 2; ++ai)
#pragma unroll
                for (int m = 0; m < 4; ++m) { const int row = row0 + ai * 128 + m * 16; const unsigned ro = b0 + (unsigned)(ai * 128 + m * 16) * 512u; const float s = rs[ai][m];
                    bool hasf; const unsigned fo = out_row_boff(kind, l, row, hasf) + (unsigned)cl * 4u;
#pragma unroll
                    for (int bj = 0; bj < 2; ++bj)
#pragma unroll
                        for (int n = 0; n < 2; ++n) { const f32x4 v = acc[ai][bj][m][n] * s; ST8(ws, ro + bj * 256 + n * 32, pk4(v));
                            if (hasf) ST16F(out, fo + bj * 512 + n * 64, v); }
                    asm volatile("" ::: "memory"); }
        } else if (t == 3 || t == 4) {
#pragma unroll
            for (int ai = 0; ai < 2; ++ai)
#pragma unroll
                for (int m = 0; m < 4; ++m) { float s = 0.f;
#pragma unroll
                    for (int bj = 0; bj < 2; ++bj)
#pragma unroll
                        for (int n = 0; n < 2; ++n) s += sq4(acc[ai][bj][m][n]);
                    s *= rs[ai][m] * rs[ai][m]; s += __shfl_xor(s, 16); s += __shfl_xor(s, 32);
                    if (fq == 0) xch[(ai * 128 + wr * 64 + m * 16 + fr) * 4 + wc] = s; }
            LDS_WAIT(); __builtin_amdgcn_s_barrier(); asm volatile("" ::: "memory");
            const float* g = (t == 3) ? g_cq : g_ckv;
            const unsigned b0 = (unsigned)((t == 3) ? WS_CQN : WS_CKVN) + (unsigned)(row0 * 256 + cl) * 2u;
            f32x4 gv[2][2];
#pragma unroll
            for (int bj = 0; bj < 2; ++bj)
#pragma unroll
                for (int n = 0; n < 2; ++n) gv[bj][n] = *(const f32x4*)(g + cl + bj * 128 + n * 16);
#pragma unroll
            for (int ai = 0; ai < 2; ++ai)
#pragma unroll
                for (int m = 0; m < 4; ++m) { const int row = row0 + ai * 128 + m * 16; const unsigned ro = b0 + (unsigned)(ai * 128 + m * 16) * 512u;
                    const f32x4 p = *(const LAS f32x4*)(xch + (ai * 128 + wr * 64 + m * 16 + fr) * 4);
                    const float tot = (p.x + p.y) + (p.z + p.w), s = rs[ai][m] * rsqrtf(tot * (1.0f / 256.0f) + EPS);
                    bool hasf; const unsigned fo = out_row_boff(2, l, row, hasf) + (unsigned)cl * 4u;
#pragma unroll
                    for (int bj = 0; bj < 2; ++bj)
#pragma unroll
                        for (int n = 0; n < 2; ++n) { const f32x4 v = acc[ai][bj][m][n] * s * gv[bj][n]; ST8(ws, ro + bj * 256 + n * 32, pk4(v));
                            if (t == 4) ST16F(out, fo + bj * 512 + n * 64, v); }
                    asm volatile("" ::: "memory"); }
        } else {
            if (wc < 2) {
#pragma unroll
                for (int ai = 0; ai < 2; ++ai)
#pragma unroll
                    for (int m = 0; m < 4; ++m) { const int row = row0 + ai * 128 + m * 16; const float s = rs[ai][m];
                        const unsigned tb = (unsigned)WS_ROPE + (unsigned)(row_pos(row) * 32 + 16 * wc + 4 * fq) * 8u;
                        const f32x4 c01 = LD16F(ws, tb), c23 = LD16F(ws, tb + 16);
                        const f32x4 x1 = acc[ai][0][m][0] * s, x2 = acc[ai][0][m][1] * s;
                        const f32x4 o1 = {x1.x * c01.x - x2.x * c01.y, x1.y * c01.z - x2.y * c01.w, x1.z * c23.x - x2.z * c23.y, x1.w * c23.z - x2.w * c23.w};
                        const f32x4 o2 = {x1.x * c01.y + x2.x * c01.x, x1.y * c01.w + x2.y * c01.z, x1.z * c23.y + x2.z * c23.x, x1.w * c23.w + x2.w * c23.z};
                        const unsigned ro = (unsigned)WS_KR + (unsigned)(row * 64 + 32 * wc + 4 * fq) * 2u; ST8(ws, ro, pk4(o1)); ST8(ws, ro + 32, pk4(o2));
                        bool hasf; const unsigned fo = out_row_boff(3, l, row, hasf) + (unsigned)(16 * wc + 4 * fq) * 4u;
                        ST16F(out, fo, o1); ST16F(out, fo + 128, o2);
                        asm volatile("" ::: "memory"); }
            }
        }
    }
};

struct EpiQup {
    static constexpr bool PERM = false, AFTER_DRAIN = false;
    unsigned char* ws;
    __device__ __forceinline__ void operator()(const f32x4 (&acc)[2][2][4][2], const pg8::Unit& u, int wr, int wc, int fr, int fq) const {
        const int row0 = u.pm * 256 + wr * 64 + fr;
        const int c00 = u.pn * 256 + wc * 32, e00 = c00 % 192, c01_ = c00 + 128, e01 = c01_ % 192;
#pragma unroll
        for (int ai = 0; ai < 2; ++ai)
#pragma unroll
            for (int m = 0; m < 4; ++m) { const int row = row0 + ai * 128 + m * 16; const unsigned ro = (unsigned)WS_QM + (unsigned)(row * 768 + 4 * fq) * 2u; const int pos = row_pos(row);
#pragma unroll
                for (int bj = 0; bj < 2; ++bj) { const int c0 = bj ? c01_ : c00, e0 = bj ? e01 : e00;
                    if (e0 >= 128) {
                        const unsigned tb = (unsigned)WS_ROPE + (unsigned)(pos * 32 + 16 * ((e0 - 128) >> 5) + 4 * fq) * 8u;
                        const f32x4 c01 = LD16F(ws, tb), c23 = LD16F(ws, tb + 16);
                        const f32x4 x1 = acc[ai][bj][m][0], x2 = acc[ai][bj][m][1];
                        const f32x4 o1 = {x1.x * c01.x - x2.x * c01.y, x1.y * c01.z - x2.y * c01.w, x1.z * c23.x - x2.z * c23.y, x1.w * c23.z - x2.w * c23.w};
                        const f32x4 o2 = {x1.x * c01.y + x2.x * c01.x, x1.y * c01.w + x2.y * c01.z, x1.z * c23.y + x2.z * c23.x, x1.w * c23.w + x2.w * c23.z};
                        ST8(ws, ro + c0 * 2, pk4(o1)); ST8(ws, ro + c0 * 2 + 32, pk4(o2));
                    } else {
                        ST8(ws, ro + c0 * 2, pk4(acc[ai][bj][m][0])); ST8(ws, ro + c0 * 2 + 32, pk4(acc[ai][bj][m][1]));
                    } }
                asm volatile("" ::: "memory"); }
    }
};
struct EpiKVup {
    static constexpr bool PERM = false, AFTER_DRAIN = false;
    unsigned char* ws;
    __device__ __forceinline__ void operator()(const f32x4 (&acc)[2][2][4][2], const pg8::Unit& u, int wr, int wc, int fr, int fq) const {
        const unsigned off0 = ((unsigned)(u.pm * 256 + wr * 64 + fr) * 512u + (unsigned)(u.pn * 128 + wc * 32 + 4 * fq)) * 2u;
#pragma unroll
        for (int ai = 0; ai < 2; ++ai)
#pragma unroll
            for (int m = 0; m < 4; ++m) { const unsigned ro = off0 + (unsigned)(ai * 128 + m * 16) * 1024u;
#pragma unroll
                for (int n = 0; n < 2; ++n) { ST8(ws, (unsigned)WS_KN + ro + n * 32, pk4(acc[ai][0][m][n])); ST8(ws, (unsigned)WS_VM + ro + n * 32, pk4(acc[ai][1][m][n])); }
                asm volatile("" ::: "memory"); }
    }
};
struct EpiResid {
    static constexpr bool PERM = false, AFTER_DRAIN = false;
    unsigned char* ws; unsigned ssq_off;
    __device__ __forceinline__ void operator()(const f32x4 (&acc)[2][2][4][2], const pg8::Unit& u, int wr, int wc, int fr, int fq) const {
        const int row0 = u.pm * 256 + wr * 64 + fr, cl = u.pn * 256 + wc * 32 + 4 * fq;
#pragma unroll
        for (int ai = 0; ai < 2; ++ai)
#pragma unroll
            for (int m = 0; m < 4; ++m) { const int row = row0 + ai * 128 + m * 16; const unsigned ro = (unsigned)WS_X + (unsigned)(row * DM + cl) * 2u; float part = 0.f;
#pragma unroll
                for (int bj = 0; bj < 2; ++bj)
#pragma unroll
                    for (int n = 0; n < 2; ++n) { const u32x2 xb = *(const u32x2*)((const char*)ws + ro + bj * 256 + n * 32); const f32x4 a = acc[ai][bj][m][n];
                        const f32x4 v = {bf_lo(xb.x) + a.x, bf_hi(xb.x) + a.y, bf_lo(xb.y) + a.z, bf_hi(xb.y) + a.w};
                        const u32x2 w = pk4(v); ST8(ws, ro + bj * 256 + n * 32, w);
                        const f32x4 q = {bf_lo(w.x), bf_hi(w.x), bf_lo(w.y), bf_hi(w.y)}; part += sq4(q); }
                part += __shfl_xor(part, 16); part += __shfl_xor(part, 32);
                if (fq == 0) *(float*)((char*)ws + ssq_off + (unsigned)(row * 16 + 4 * u.pn + wc) * 4u) = part;
                asm volatile("" ::: "memory"); }
    }
};
struct EpiFfnUp {
    static constexpr bool PERM = true, AFTER_DRAIN = false;
    unsigned char* ws;
    __device__ __forceinline__ void operator()(const f32x4 (&acc)[2][2][4][2], const pg8::Unit& u, int wr, int wc, int fr, int fq) const {
        const int row0 = u.pm * 256 + wr * 64 + fr, cl = u.pn * 256 + wc * 32 + 8 * fq;
#pragma unroll
        for (int ai = 0; ai < 2; ++ai)
#pragma unroll
            for (int m = 0; m < 4; ++m) { const int row = row0 + ai * 128 + m * 16; const float s = row_rs((const float*)(ws + WS_SSQB), row, fq); const unsigned ro = (unsigned)WS_U + ((unsigned)row * DFF + (unsigned)cl) * 2u;
#pragma unroll
                for (int bj = 0; bj < 2; ++bj) { f32x4 v0 = acc[ai][bj][m][0] * s, v1 = acc[ai][bj][m][1] * s;
                    v0 = __builtin_elementwise_max(v0, (f32x4){0.f, 0.f, 0.f, 0.f}); v1 = __builtin_elementwise_max(v1, (f32x4){0.f, 0.f, 0.f, 0.f});
                    v0 = v0 * v0; v1 = v1 * v1;
                    u32x4 w; w.x = pk2(v0.x, v0.y); w.y = pk2(v0.z, v0.w); w.z = pk2(v1.x, v1.y); w.w = pk2(v1.z, v1.w);
                    *(u32x4*)((char*)ws + ro + bj * 256) = w; }
                asm volatile("" ::: "memory"); }
    }
};

template <class Map>
__device__ __forceinline__ void tr_item(const float* W, int K, int Nsrc, bf16_t* WT, int Ndst, const float* rowgain, LAS float* scr, int item, int lane, const Map& map) {
    const int nblk = Ndst / 32, kb = item / nblk, nb = item % nblk, k0 = 64 * kb, n0 = 32 * nb;
    float cs = 1.f; const int sc = map(n0 + (lane & 31), cs);
#pragma unroll 8
    for (int i = 0; i < 32; ++i) { const int kk = 2 * i + (lane >> 5); float v = 0.f;
        if (sc >= 0) { v = W[(size_t)(k0 + kk) * Nsrc + sc] * cs; if (rowgain) v *= rowgain[k0 + kk]; }
        scr[kk * 33 + (lane & 31)] = v; }
    LDS_WAIT(); asm volatile("" ::: "memory");
    const int c = lane & 7;
#pragma unroll
    for (int j = 0; j < 4; ++j) { const int n = (lane >> 3) + 8 * j; const LAS float* s = scr + (8 * c) * 33 + n;
        u32x4 o; o.x = pk2(s[0 * 33], s[1 * 33]); o.y = pk2(s[2 * 33], s[3 * 33]); o.z = pk2(s[4 * 33], s[5 * 33]); o.w = pk2(s[6 * 33], s[7 * 33]);
        *(u32x4*)(WT + (size_t)(n0 + n) * K + k0 + 8 * c) = o; }
    LDS_WAIT(); asm volatile("" ::: "memory");
}
struct MapIdent { __device__ __forceinline__ int operator()(int n, float& cs) const { cs = 1.f; return n; } };
struct MapWin { __device__ __forceinline__ int operator()(int n, float& cs) const {
    const int t = n >> 8, c = n & 255; cs = (t == 0) ? 0.125f * LOG2E : (t == 5) ? 0.125f : 1.f;
    if (t < 5) return n;
    if (t < 8) return 1344 + (n - 1280);
    if (c >= 64) return -1;
    return 1280 + 16 * (c >> 5) + (c & 15) + 32 * ((c >> 4) & 1); } };
struct MapWuq { __device__ __forceinline__ int operator()(int n, float& cs) const {
    cs = 0.07216878364870322f * LOG2E;
    const int h = n / 192, e = n % 192; if (e < 128) return n;
    const int p = e - 128; return h * 192 + 128 + 16 * (p >> 5) + (p & 15) + 32 * ((p >> 4) & 1); } };

__device__ __forceinline__ void prologue(const Ctx& C) {
    LAS float* scr = (LAS float*)(C.lds + C.wave * 16384);
    constexpr int I_IN = (DM / 64) * (NIN / 32), I_UQ = (256 / 64) * (768 / 32), I_UKV = (256 / 64) * (1024 / 32), I_OUT = (DM / 64) * (DM / 32), I_UP = (DM / 64) * (DFF / 32), I_DN = (DFF / 64) * (DM / 32);
    constexpr int I_L = I_IN + I_UQ + I_UKV + I_OUT + I_UP + I_DN;
    for (int it = C.gw; it < DEPTH * I_L; it += C.ngw) {
        const int l = it / I_L; int r = it % I_L;
        if (r < I_IN) { tr_item(CIN(9) + (size_t)l * DM * INC, DM, INC, WSP(bf16_t, WS_WIN) + (size_t)l * NIN * DM, NIN, CIN(8) + l * DM, scr, r, C.lane, MapWin()); continue; } r -= I_IN;
        if (r < I_UQ) { tr_item(CIN(12) + (size_t)l * 256 * 768, 256, 768, WSP(bf16_t, WS_WUQ) + (size_t)l * 768 * 256, 768, nullptr, scr, r, C.lane, MapWuq()); continue; } r -= I_UQ;
        if (r < I_UKV) { tr_item(CIN(13) + (size_t)l * 256 * 1024, 256, 1024, WSP(bf16_t, WS_WUKV) + (size_t)l * 1024 * 256, 1024, nullptr, scr, r, C.lane, MapIdent()); continue; } r -= I_UKV;
        if (r < I_OUT) { tr_item(CIN(18) + (size_t)l * DM * DM, DM, DM, WSP(bf16_t, WS_WOUT) + (size_t)l * DM * DM, DM, nullptr, scr, r, C.lane, MapIdent()); continue; } r -= I_OUT;
        if (r < I_UP) { tr_item(CIN(20) + (size_t)l * DM * DFF, DM, DFF, WSP(bf16_t, WS_WUP) + (size_t)l * DFF * DM, DFF, CIN(19) + l * DM, scr, r, C.lane, MapIdent()); continue; } r -= I_UP;
        tr_item(CIN(21) + (size_t)l * DFF * DM, DFF, DM, WSP(bf16_t, WS_WDN) + (size_t)l * DM * DFF, DM, nullptr, scr, r, C.lane, MapIdent());
    }
    {
        float* tab = WSP(float, WS_ROPE);
        for (int e = C.gw * 64 + C.lane; e < 8192 * 32; e += C.ngw * 64) {
            const int pos = e >> 5, i = e & 31;
            double inv = 1.0; for (int k = 0; k < i; ++k) inv *= 0.74989420933245582730;
            const float ang = (float)pos * (float)inv;
            const double a = (double)ang, n = __builtin_rint(a * 0.15915494309189533577), r = (a - n * 6.283185307179586232) - n * 2.449293598294706414e-16, r2 = r * r;
            double s = 1.0, c = 1.0;
#pragma unroll
            for (int k = 13; k >= 1; --k) { s = 1.0 - r2 * (1.0 / (double)((2 * k) * (2 * k + 1))) * s; c = 1.0 - r2 * (1.0 / (double)((2 * k - 1) * (2 * k))) * c; }
            tab[2 * e] = (float)c; tab[2 * e + 1] = (float)(r * s);
        }
    }
    {
        bf16_t* X = WSP(bf16_t, WS_X); float* ssq = WSP(float, WS_SSQA);
        for (int row = C.gw; row < T; row += C.ngw) {
            const float* xr = (row < TP) ? CIN(0) + (size_t)row * DM : CIN(1) + (size_t)(row - TP) * DM;
            f32x4 v[4]; u32x2 w[4]; float s = 0.f;
#pragma unroll
            for (int j = 0; j < 4; ++j) { v[j] = *(const f32x4*)(xr + 256 * j + 4 * C.lane); w[j] = pk4(v[j]);
                const f32x4 q = {bf_lo(w[j].x), bf_hi(w[j].x), bf_lo(w[j].y), bf_hi(w[j].y)}; s += sq4(q); }
#pragma unroll
            for (int o = 1; o < 64; o <<= 1) s += __shfl_xor(s, o);
#pragma unroll
            for (int j = 0; j < 4; ++j) *(u32x2*)(X + (size_t)row * DM + 256 * j + 4 * C.lane) = w[j];
            if (C.lane < 16) ssq[(size_t)row * 16 + C.lane] = (C.lane == 0) ? s : 0.f;
        }
    }
}

__device__ __forceinline__ void convert_caches(const Ctx& C, int l) {
    constexpr int SEGC = 524288;
    const int gt = C.gw * 64 + C.lane, ngt = C.ngw * 64;
    for (int ci = gt; ci < 15 * SEGC; ci += ngt) {
        const int seg = ci / SEGC; const size_t e0 = (size_t)(ci % SEGC) * 8;
        const float* src; bf16_t* dst; size_t eo = e0;
        if (seg < 2) { src = CIN(2 + seg) + (size_t)l * DBATCH * LA * 256; dst = WSP(bf16_t, seg == 0 ? WS_KA : WS_VA) + (size_t)T * 256; }
        else if (seg < 6) { eo = e0 + (size_t)(seg - 2) * 4194304; src = CIN(6) + (size_t)l * DBATCH * PAST * 256; dst = WSP(bf16_t, WS_KC) + (size_t)T * 256; }
        else if (seg < 10) { eo = e0 + (size_t)(seg - 6) * 4194304; src = CIN(7) + (size_t)l * DBATCH * PAST * 256; dst = WSP(bf16_t, WS_VC) + (size_t)T * 256; }
        else if (seg < 14) { eo = e0 + (size_t)(seg - 10) * 4194304; src = CIN(4) + (size_t)l * DBATCH * PAST * 256; dst = WSP(bf16_t, WS_CKVN) + (size_t)T * 256; }
        else { src = CIN(5) + (size_t)l * DBATCH * PAST * 64; dst = WSP(bf16_t, WS_KR) + (size_t)T * 64; }
        const f32x4 a = *(const f32x4*)(src + eo), b = *(const f32x4*)(src + eo + 4);
        u32x4 w; w.x = pk2(a.x, a.y); w.y = pk2(a.z, a.w); w.z = pk2(b.x, b.y); w.w = pk2(b.z, b.w);
        size_t edst = eo;
        if (seg == 14) { const int c = (int)(eo & 63); edst = (eo & ~(size_t)63) + 32 * ((c & 31) >> 4) + 16 * (c >> 5) + (c & 15); }
        *(u32x4*)(dst + edst) = w;
        if (seg < 2) { const int bb = (int)(e0 / (LA * 256)), s = (int)(e0 / 256) % LA, c = (int)(e0 % 256);
            if (s >= DSEQ) { float* o = COUT + (seg == 0 ? OFF_SAK : OFF_SAV) + ((long)((l * DBATCH + bb) * LA + s - DSEQ)) * 256 + c; *(f32x4*)o = a; *(f32x4*)(o + 4) = b; } }
    }
}

__device__ __forceinline__ void norm_mixer(const Ctx& C, int l) {
    bf16_t* O = WSP(bf16_t, WS_O);
    const int lane = C.lane; const bool isM = (lane >= 16 && lane < 48);
    const float* g = lane < 16 ? CIN(15) + l * 256 + 16 * lane : isM ? CIN(16) + l * 512 + 16 * (lane - 16) : CIN(17) + l * 256 + 16 * (lane - 48);
    f32x4 gv[4];
#pragma unroll
    for (int j = 0; j < 4; ++j) gv[j] = *(const f32x4*)(g + 4 * j);
    for (int row = C.gw; row < T; row += C.ngw) {
        bf16_t* rp = O + (size_t)row * DM + 16 * lane;
        const u32x4 w0 = *(const u32x4*)rp, w1 = *(const u32x4*)(rp + 8);
        f32x4 v[4] = {{bf_lo(w0.x), bf_hi(w0.x), bf_lo(w0.y), bf_hi(w0.y)}, {bf_lo(w0.z), bf_hi(w0.z), bf_lo(w0.w), bf_hi(w0.w)},
                      {bf_lo(w1.x), bf_hi(w1.x), bf_lo(w1.y), bf_hi(w1.y)}, {bf_lo(w1.z), bf_hi(w1.z), bf_lo(w1.w), bf_hi(w1.w)}};
        float s = (sq4(v[0]) + sq4(v[1])) + (sq4(v[2]) + sq4(v[3]));
        s += __shfl_xor(s, 1); s += __shfl_xor(s, 2); s += __shfl_xor(s, 4); s += __shfl_xor(s, 8);
        const float so = __shfl_xor(s, 48);
        const float rs = isM ? rsqrtf((s + so) * (1.0f / 512.0f) + EPS) : rsqrtf(s * (1.0f / 256.0f) + EPS);
#pragma unroll
        for (int j = 0; j < 4; ++j) v[j] = v[j] * rs * gv[j];
        u32x4 o0, o1; o0.x = pk2(v[0].x, v[0].y); o0.y = pk2(v[0].z, v[0].w); o0.z = pk2(v[1].x, v[1].y); o0.w = pk2(v[1].z, v[1].w);
        o1.x = pk2(v[2].x, v[2].y); o1.y = pk2(v[2].z, v[2].w); o1.z = pk2(v[3].x, v[3].y); o1.w = pk2(v[3].z, v[3].w);
        *(u32x4*)rp = o0; *(u32x4*)(rp + 8) = o1;
    }
}

__device__ __forceinline__ void final_norm(const Ctx& C) {
    const bf16_t* X = WSP(bf16_t, WS_X); const float* ssq = WSP(float, WS_SSQA); const float* g = CIN(22);
    for (int row = C.gw; row < T; row += C.ngw) {
        const f32x4 p0 = *(const f32x4*)(ssq + (size_t)row * 16), p1 = *(const f32x4*)(ssq + (size_t)row * 16 + 4), p2 = *(const f32x4*)(ssq + (size_t)row * 16 + 8), p3 = *(const f32x4*)(ssq + (size_t)row * 16 + 12);
        const float tot = ((p0.x + p0.y) + (p0.z + p0.w)) + ((p1.x + p1.y) + (p1.z + p1.w)) + ((p2.x + p2.y) + (p2.z + p2.w)) + ((p3.x + p3.y) + (p3.z + p3.w));
        const float rs = rsqrtf(tot * (1.0f / DM) + EPS);
#pragma unroll
        for (int j = 0; j < 2; ++j) { const int c = 512 * j + 8 * C.lane; const u32x4 w = *(const u32x4*)(X + (size_t)row * DM + c);
            const f32x4 g0 = *(const f32x4*)(g + c), g1 = *(const f32x4*)(g + c + 4);
            const f32x4 a = {bf_lo(w.x) * rs * g0.x, bf_hi(w.x) * rs * g0.y, bf_lo(w.y) * rs * g0.z, bf_hi(w.y) * rs * g0.w};
            const f32x4 b = {bf_lo(w.z) * rs * g1.x, bf_hi(w.z) * rs * g1.y, bf_lo(w.w) * rs * g1.z, bf_hi(w.w) * rs * g1.w};
            float* o = COUT + OFF_Y + (size_t)row * DM + c; *(f32x4*)o = a; *(f32x4*)(o + 4) = b; }
    }
}

struct AttnDesc { int qrow0, nact, cq0, cbase, ncache, nbase, head; };

#define MFMA32(a, b, c) __builtin_amdgcn_mfma_f32_32x32x16_bf16((a), (b), (c), 0, 0, 0)
__device__ __forceinline__ s16x4 tr16(const LAS unsigned char* p) {
    typedef short v4i16_t __attribute__((ext_vector_type(4)));
    return __builtin_bit_cast(s16x4, __builtin_amdgcn_ds_read_tr16_b64_v4i16((LAS v4i16_t*)p)); }
__device__ __forceinline__ bf16x8 pack8(const f32x16& x, int s) {
    u32x4 p; p.x = pk2(x[8 * s + 0], x[8 * s + 1]); p.y = pk2(x[8 * s + 2], x[8 * s + 3]); p.z = pk2(x[8 * s + 4], x[8 * s + 5]); p.w = pk2(x[8 * s + 6], x[8 * s + 7]);
    return __builtin_bit_cast(bf16x8, p); }
__device__ __forceinline__ float half_max(float m) { auto rr = __builtin_amdgcn_permlane32_swap(__float_as_uint(m), __float_as_uint(m), false, false);
    return fmaxf(__uint_as_float(rr[0]), __uint_as_float(rr[1])); }
__device__ __forceinline__ float half_sum(float m) { auto rr = __builtin_amdgcn_permlane32_swap(__float_as_uint(m), __float_as_uint(m), false, false);
    return __uint_as_float(rr[0]) + __uint_as_float(rr[1]); }

template <int KIND>
__device__ __forceinline__ void attn_unit(const Ctx& C, const AttnDesc d, const bf16_t* Q, const bf16_t* K, const bf16_t* Kr, const bf16_t* V, bf16_t* O, const float* biasg) {
    constexpr int DQK = (KIND == 0) ? 192 : 64, DV = (KIND == 0) ? 128 : 64, NKS = DQK / 16, NDB = DV / 32;
    constexpr int QP = (KIND == 0) ? 768 : 256, KP = (KIND == 0) ? 512 : 256;
    constexpr int KSTR = (KIND == 0) ? 400 : 144, VSTR = (KIND == 0) ? 320 : 192;
    constexpr int STAGE = 64 * KSTR + 64 * VSTR, NP = (KIND == 0) ? 5 : 2;
    constexpr int LDS_TAB = 98304, LDS_FLAGS = LDS_MISC + 32;
    const int tid = C.tid, lane = C.lane, w = C.wave, r = lane & 31, hh = lane >> 5;
    const bool wact = w < d.nact;
    const int cw = d.cq0 + (w >> 1);
    const int ctop = d.cq0 + (d.nact == 8 ? 3 : 0);
    const int kmin = (KIND == 1) ? (d.cq0 > 8 ? d.cq0 - 8 : 0) : 0;
    const int nt = ctop - kmin + 1;
    const int qrow = d.qrow0 + 32 * w + r;
    bf16x8 qf[NKS];
    if (wact) {
#pragma unroll
        for (int ks = 0; ks < NKS; ++ks) qf[ks] = *(const bf16x8*)(Q + (size_t)qrow * QP + d.head * DQK + ks * 16 + hh * 8);
    } else {
#pragma unroll
        for (int ks = 0; ks < NKS; ++ks) qf[ks] = (bf16x8){0, 0, 0, 0, 0, 0, 0, 0};
    }
    if (KIND == 1) { if (tid < 192) ((LAS float*)(C.lds + LDS_TAB))[tid] = biasg[tid] * LOG2E; }
    f32x16 o[NDB];
#pragma unroll
    for (int db = 0; db < NDB; ++db)
#pragma unroll
        for (int i = 0; i < 16; ++i) o[db][i] = 0.f;
    float mrun = -1e30f, lsum = 0.f, Crun = 0.f; bool started = false;
    u32x4 st[NP];
#define kc_of(jt__) ((KIND == 2) ? (ctop - (jt__)) : (kmin + (jt__)))
#define STAGE_LOAD(jt_) do { const int kc_ = kc_of(jt_); const size_t rb_ = (size_t)(kc_ < d.ncache ? d.cbase + 64 * kc_ : d.nbase); \
        if (KIND == 0) { \
            _Pragma("unroll") for (int p_ = 0; p_ < 2; ++p_) { const int idx_ = p_ * 512 + tid; st[p_] = *(const u32x4*)(K + (rb_ + (idx_ >> 4)) * KP + d.head * 128 + (idx_ & 15) * 8); } \
            st[2] = *(const u32x4*)(Kr + (rb_ + (tid >> 3)) * 64 + (tid & 7) * 8); \
            _Pragma("unroll") for (int p_ = 0; p_ < 2; ++p_) { const int idx_ = p_ * 512 + tid; st[3 + p_] = *(const u32x4*)(V + (rb_ + (idx_ >> 4)) * KP + d.head * 128 + (idx_ & 15) * 8); } \
        } else { \
            st[0] = *(const u32x4*)(K + (rb_ + (tid >> 3)) * KP + d.head * 64 + (tid & 7) * 8); \
            st[1] = *(const u32x4*)(V + (rb_ + (tid >> 3)) * KP + d.head * 64 + (tid & 7) * 8); \
        } } while (0)
#define STAGE_STORE(buf_) do { LAS unsigned char* kb_ = C.lds + (buf_) * STAGE; LAS unsigned char* vb_ = kb_ + 64 * KSTR; \
        if (KIND == 0) { \
            _Pragma("unroll") for (int p_ = 0; p_ < 2; ++p_) { const int idx_ = p_ * 512 + tid; *(LAS u32x4*)(kb_ + (idx_ >> 4) * KSTR + (idx_ & 15) * 16) = st[p_]; } \
            *(LAS u32x4*)(kb_ + (tid >> 3) * KSTR + 256 + (tid & 7) * 16) = st[2]; \
            _Pragma("unroll") for (int p_ = 0; p_ < 2; ++p_) { const int idx_ = p_ * 512 + tid; *(LAS u32x4*)(vb_ + (idx_ >> 4) * VSTR + (idx_ & 15) * 16) = st[3 + p_]; } \
        } else { \
            *(LAS u32x4*)(kb_ + (tid >> 3) * KSTR + (tid & 7) * 16) = st[0]; \
            *(LAS u32x4*)(vb_ + (tid >> 3) * VSTR + (tid & 7) * 16) = st[1]; \
        } } while (0)
    STAGE_LOAD(0); STAGE_STORE(0);
    __syncthreads();
    const int q4 = (lane & 15) >> 2, p4 = lane & 3, blk = (lane >> 4) & 1;
    const int qin = 32 * (w & 1) + r;
    int buf = 0;
    for (int jt = 0; jt < nt; ++jt) {
        const bool more = jt + 1 < nt;
        if (more) STAGE_LOAD(jt + 1);
        const int kc = kc_of(jt);
        bool act = wact && kc <= cw;
        if (KIND == 1) act = act && (cw - kc <= 8);
        if (act) {
            const LAS unsigned char* Kb = C.lds + buf * STAGE; const LAS unsigned char* Vb = Kb + 64 * KSTR;
            f32x16 s0, s1;
#pragma unroll
            for (int i = 0; i < 16; ++i) { s0[i] = 0.f; s1[i] = 0.f; }
#pragma unroll
            for (int ks = 0; ks < NKS; ++ks) {
                const bf16x8 a0 = *(const LAS bf16x8*)(Kb + r * KSTR + ks * 32 + hh * 16);
                const bf16x8 a1 = *(const LAS bf16x8*)(Kb + (32 + r) * KSTR + ks * 32 + hh * 16);
                s0 = MFMA32(a0, qf[ks], s0); s1 = MFMA32(a1, qf[ks], s1);
            }
            if (KIND != 2) {
                if (KIND == 1) {
                    const LAS float* tab = (const LAS float*)(C.lds + LDS_TAB);
                    const int bc = kc - cw + 8;
                    if (bc <= 5) { const float cb = tab[191];
#pragma unroll
                        for (int i = 0; i < 16; ++i) { s0[i] += cb; s1[i] += cb; }
                    } else {
                        const int db0 = 64 * (8 - bc) + qin - 4 * hh;
#pragma unroll
                        for (int i = 0; i < 16; ++i) { const int d0 = db0 - ((i & 3) + 8 * (i >> 2)), d1 = d0 - 32;
                            s0[i] += tab[(d0 > 128 ? 128 : d0) + 63]; s1[i] += tab[(d1 > 128 ? 128 : d1) + 63]; }
                    }
                }
                float mx = fmaxf(s0[0], s1[0]);
#pragma unroll
                for (int i = 1; i < 16; ++i) mx = fmaxf(mx, fmaxf(s0[i], s1[i]));
                mx = half_max(mx);
                const float mn = fmaxf(mrun, mx), alpha = __builtin_amdgcn_exp2f(mrun - mn); mrun = mn;
                float ps = 0.f;
#pragma unroll
                for (int i = 0; i < 16; ++i) { s0[i] = __builtin_amdgcn_exp2f(s0[i] - mn); s1[i] = __builtin_amdgcn_exp2f(s1[i] - mn); ps += s0[i] + s1[i]; }
                lsum = lsum * alpha + ps;
#pragma unroll
                for (int db = 0; db < NDB; ++db)
#pragma unroll
                    for (int i = 0; i < 16; ++i) o[db][i] *= alpha;
            } else {
                started = true;
                const bool diag = (kc == cw);
#pragma unroll
                for (int kb = 1; kb >= 0; --kb) {
                    f32x16& sT = kb ? s1 : s0;
                    float lg[16], G[4], PG[4];
#pragma unroll
                    for (int i = 0; i < 16; ++i) { const float z = sT[i]; const bool valid = !diag || (32 * kb + (i & 3) + 8 * (i >> 2) + 4 * hh < qin);
                        const float sp = fmaxf(z, 0.f) + LN2 * __builtin_amdgcn_logf(1.0f + __builtin_amdgcn_exp2f(-fabsf(z) * LOG2E));
                        lg[i] = valid ? -sp : 0.f; sT[i] = valid ? z : -1e30f; }
#pragma unroll
                    for (int g = 0; g < 4; ++g) { G[g] = (lg[4 * g] + lg[4 * g + 1]) + (lg[4 * g + 2] + lg[4 * g + 3]); PG[g] = __shfl_xor(G[g], 32); }
                    float run = Crun;
#pragma unroll
                    for (int g = 3; g >= 0; --g) {
                        float cex = run + (hh == 0 ? PG[g] : 0.f);
#pragma unroll
                        for (int e = 3; e >= 0; --e) { const int i = 4 * g + e; const float arg = fminf(sT[i] + lg[i] + cex, 0.f);
                            cex += lg[i]; sT[i] = __builtin_amdgcn_exp2f(arg * LOG2E); }
                        run += G[g] + PG[g];
                    }
                    Crun = run;
                }
            }
#pragma unroll
            for (int s2 = 0; s2 < 4; ++s2) {
                const bf16x8 pf = pack8(s2 < 2 ? s0 : s1, s2 & 1);
#pragma unroll
                for (int db = 0; db < NDB; ++db) {
                    const LAS unsigned char* va = Vb + (16 * s2 + 4 * hh + q4) * VSTR + (32 * db + 16 * blk + 4 * p4) * 2;
                    const s16x4 lo = tr16(va), hi = tr16(va + 8 * VSTR);
                    const bf16x8 vf = {lo[0], lo[1], lo[2], lo[3], hi[0], hi[1], hi[2], hi[3]};
                    o[db] = MFMA32(vf, pf, o[db]);
                }
            }
        }
        if (more) STAGE_STORE(buf ^ 1);
        if (KIND == 2) {
            const bool done = !wact || (started && (__ballot(Crun > -104.0f) == 0ull));
            if (lane == 0) ((LAS unsigned*)(C.lds + LDS_FLAGS))[(jt & 1) * 8 + w] = done ? 1u : 0u;
        }
        __syncthreads();
        if (KIND == 2) {
            const LAS u32x4* fl = (const LAS u32x4*)(C.lds + LDS_FLAGS + (jt & 1) * 32);
            const u32x4 f0 = fl[0], f1 = fl[1];
            if ((f0.x & f0.y & f0.z & f0.w & f1.x & f1.y & f1.z & f1.w) != 0u) break;
        }
        buf ^= 1;
    }
#undef STAGE_LOAD
#undef STAGE_STORE
#undef kc_of
    if (wact) {
        float inv = 1.f;
        if (KIND != 2) { const float lt = half_sum(lsum); inv = 1.0f / lt; }
        bf16_t* op = O + (size_t)qrow * DM + d.head * DV;
#pragma unroll
        for (int db = 0; db < NDB; ++db)
#pragma unroll
            for (int g = 0; g < 4; ++g) { const f32x4 v = {o[db][4 * g] * inv, o[db][4 * g + 1] * inv, o[db][4 * g + 2] * inv, o[db][4 * g + 3] * inv};
                *(u32x2*)(op + 32 * db + 8 * g + 4 * hh) = pk4(v); }
    }
    __syncthreads();
}

constexpr int NU_ATT = 3456;
__device__ __forceinline__ void attn_phase(const Ctx& C, int l) {
    gu32* head = (gu32*)(CWS + WS_CTL) + CW_QUEUE + 64 * l;
    LAS unsigned* bc = (LAS unsigned*)(C.lds + LDS_MISC + 16);
    const bf16_t *QA = WSP(bf16_t, WS_QA), *KA = WSP(bf16_t, WS_KA), *VA = WSP(bf16_t, WS_VA), *QC = WSP(bf16_t, WS_QC), *KC = WSP(bf16_t, WS_KC), *VC = WSP(bf16_t, WS_VC);
    const bf16_t *QM = WSP(bf16_t, WS_QM), *KN = WSP(bf16_t, WS_KN), *VM = WSP(bf16_t, WS_VM), *KR = WSP(bf16_t, WS_KR);
    bf16_t* O = WSP(bf16_t, WS_O);
    for (;;) {
        if (C.tid == 0) bc[0] = __hip_atomic_fetch_add(head, 1u, __ATOMIC_RELAXED, __HIP_MEMORY_SCOPE_AGENT);
        __syncthreads();
        const int u = (int)bc[0];
        __syncthreads();
        if (u >= NU_ATT) break;
        AttnDesc d;
        if (u < 1152) {
            if (u < 1024) { const int qb = 31 - (u >> 5), bh = u & 31, b = bh >> 2; d.head = bh & 3; d.qrow0 = b * SEQ + 256 * qb; d.nact = 8; d.cq0 = 4 * qb; d.cbase = b * SEQ; d.ncache = 1 << 20; d.nbase = 0; }
            else { const int i = u - 1024, b = i >> 2; d.head = i & 3; d.qrow0 = TP + 64 * b; d.nact = 2; d.cq0 = PAST / 64; d.cbase = T + b * PAST; d.ncache = PAST / 64; d.nbase = TP + 64 * b; }
            attn_unit<0>(C, d, QM, KN, KR, VM, O + 256, nullptr);
        } else if (u < 2304) {
            if (u < 2176) { const int i = u - 1152, g = 31 - (i >> 5), bh = i & 31, b = bh >> 2; d.head = bh & 3; d.qrow0 = b * SEQ + 256 * g; d.nact = 8; d.cq0 = 4 * g; d.cbase = b * SEQ; d.ncache = 1 << 20; d.nbase = 0; }
            else { const int i = u - 2176, b = i >> 2; d.head = i & 3; d.qrow0 = TP + 64 * b; d.nact = 2; d.cq0 = LA / 64; d.cbase = T + b * LA; d.ncache = LA / 64; d.nbase = TP + 64 * b; }
            attn_unit<1>(C, d, QA, KA, nullptr, VA, O, CIN(14) + (size_t)(l * 4 + d.head) * 192);
        } else {
            if (u < 3328) { const int i = u - 2304, qb = 31 - (i >> 5), bh = i & 31, b = bh >> 2; d.head = bh & 3; d.qrow0 = b * SEQ + 256 * qb; d.nact = 8; d.cq0 = 4 * qb; d.cbase = b * SEQ; d.ncache = 1 << 20; d.nbase = 0; }
            else { const int i = u - 3328, b = i >> 2; d.head = i & 3; d.qrow0 = TP + 64 * b; d.nact = 2; d.cq0 = PAST / 64; d.cbase = T + b * PAST; d.ncache = PAST / 64; d.nbase = TP + 64 * b; }
            attn_unit<2>(C, d, QC, KC, nullptr, VC, O + 768, nullptr);
        }
    }
}

constexpr int PH_PER_LAYER = 7, N_PHASES = 1 + DEPTH * PH_PER_LAYER + 1;

__global__ void __launch_bounds__(NTHREADS, 2) mk_fwd(Args args) {
    extern __shared__ __attribute__((aligned(16))) unsigned char lds_raw[];
    Ctx C;
    C.lds = (LAS unsigned char*)lds_raw;
    const int wave0 = __builtin_amdgcn_readfirstlane((int)threadIdx.x >> 6);
    C.wave = wave0; C.bid = blockIdx.x; C.lane = fresh_lane(); C.tid = C.wave * 64 + C.lane;
    C.G = gridDim.x; C.gw = blockIdx.x * NWAVES + C.wave; C.ngw = C.G * NWAVES;
    C.a = &args; C.ws_ = (unsigned long long)args.ws; C.out_ = (unsigned long long)args.out;
    for (int u = C.tid; u < (LDS_BYTES - LDS_MISC) / 4; u += NTHREADS) ((LAS unsigned*)(C.lds + LDS_MISC))[u] = 0u;
    __syncthreads();
    unsigned* ctl = (unsigned*)(CWS + WS_CTL);
    const int lo = args.ph_lo, hi = args.ph_hi;
    const bool one = (hi - lo) > 1;
    XcdBarrier bar; bar.bar = ctl + CW_BAR; bar.x = 0; bar.st = nullptr;
    if (one) bar = xcd_barrier_post(ctl + CW_BAR, (volatile LAS unsigned*)(C.lds + LDS_MISC), C.tid == 0);
#ifndef MK_EN
#define MK_EN 0xffff
#endif
#define IN(k) (lo <= (k) && (k) < hi)
#define FRESH() do { unsigned z_; asm volatile("s_mov_b32 %0, 0" : "=s"(z_)); C.ws_ = (unsigned long long)args.ws + z_; C.out_ = (unsigned long long)args.out + z_; \
    C.wave = wave0 + (int)z_; C.bid = (int)blockIdx.x + (int)z_; C.G = (int)gridDim.x + (int)z_; C.gw = C.bid * NWAVES + C.wave; C.ngw = C.G * NWAVES; C.lane = fresh_lane(); C.tid = C.wave * 64 + C.lane; } while (0)
#define SEAM(k) do { if (IN(k) && IN((k) + 1)) { const int l_ = fresh_lane(); xcd_barrier(bar, C.wave == 0 && l_ == 0); } } while (0)
    LAS unsigned char* ring = C.lds;

    if ((MK_EN & 1) && IN(0)) { FRESH(); prologue(C); } SEAM(0);

    for (int l = 0; l < DEPTH; ++l) {
        const int p0 = 1 + l * PH_PER_LAYER;
        if ((MK_EN & 2) && IN(p0)) {
            FRESH();
            pg8::Gemm g{WSP(bf16_t, WS_X), WSP(bf16_t, WS_WIN) + (size_t)l * NIN * DM, T, NIN, DM}; pg8::StaticOrder S; S.init(T, NIN, C.G, C.bid);
            EpiIn E{CWS, COUT, l, CIN(10) + l * 256, CIN(11) + l * 256, (LAS float*)(C.lds + LDS_XCH)};
            pg8::gemm_phase<EpiIn, pg8::StaticOrder, true, true>(ring, g, S, E, C.wave);
            FRESH(); convert_caches(C, l);
        }
        SEAM(p0);
        if ((MK_EN & 4) && IN(p0 + 1)) {
            FRESH();
            if (MK_EN & 0x1000) { pg8::Gemm g{WSP(bf16_t, WS_CQN), WSP(bf16_t, WS_WUQ) + (size_t)l * 768 * 256, T, 768, 256}; pg8::StaticOrder S; S.init(T, 768, C.G, C.bid);
              EpiQup E{CWS};
              pg8::gemm_phase<EpiQup, pg8::StaticOrder, true, true>(ring, g, S, E, C.wave); }
            FRESH();
            if (MK_EN & 0x2000) { pg8::Gemm g{WSP(bf16_t, WS_CKVN), WSP(bf16_t, WS_WUKV) + (size_t)l * 1024 * 256, EC, 1024, 256}; pg8::StaticOrder S; S.init(EC, 1024, C.G, C.bid);
              EpiKVup E{CWS};
              pg8::gemm_phase<EpiKVup, pg8::StaticOrder, true, true>(ring, g, S, E, C.wave); }
        }
        SEAM(p0 + 1);
        if ((MK_EN & 8) && IN(p0 + 2)) { FRESH(); attn_phase(C, l); }
        SEAM(p0 + 2);
        if ((MK_EN & 16) && IN(p0 + 3)) { FRESH(); norm_mixer(C, l); }
        SEAM(p0 + 3);
        if ((MK_EN & 32) && IN(p0 + 4)) {
            FRESH();
            pg8::Gemm g{WSP(bf16_t, WS_O), WSP(bf16_t, WS_WOUT) + (size_t)l * DM * DM, T, DM, DM}; pg8::StaticOrder S; S.init(T, DM, C.G, C.bid);
            EpiResid E{CWS, (unsigned)WS_SSQB};
            pg8::gemm_phase<EpiResid, pg8::StaticOrder, true, true>(ring, g, S, E, C.wave);
        }
        SEAM(p0 + 4);
        if ((MK_EN & 64) && IN(p0 + 5)) {
            FRESH();
            pg8::Gemm g{WSP(bf16_t, WS_X), WSP(bf16_t, WS_WUP) + (size_t)l * DFF * DM, T, DFF, DM}; pg8::StaticOrder S; S.init(T, DFF, C.G, C.bid);
            EpiFfnUp E{CWS};
            pg8::gemm_phase<EpiFfnUp, pg8::StaticOrder, true, true>(ring, g, S, E, C.wave);
        }
        SEAM(p0 + 5);
        if ((MK_EN & 128) && IN(p0 + 6)) {
            FRESH();
            pg8::Gemm g{WSP(bf16_t, WS_U), WSP(bf16_t, WS_WDN) + (size_t)l * DM * DFF, T, DM, DFF}; pg8::StaticOrder S; S.init(T, DM, C.G, C.bid);
            EpiResid E{CWS, (unsigned)WS_SSQA};
            pg8::gemm_phase<EpiResid, pg8::StaticOrder, true, true>(ring, g, S, E, C.wave);
        }
        SEAM(p0 + 6);
    }
    if ((MK_EN & 256) && IN(N_PHASES - 1)) { FRESH(); final_norm(C); }
#undef IN
#undef SEAM
}

#ifndef MK_SPLIT
#define MK_SPLIT 0
#endif
extern "C" void kernel_launch(void* const* d_in, const int* in_sizes, int n_in, void* d_out, int out_size, void* d_ws, size_t ws_size, hipStream_t stream) {
    static int grid = 0;
    if (grid == 0) {
        if (n_in != 23 || (long)out_size != OUT_TOTAL || ws_size < WS_END) { fprintf(stderr, "kernel_launch: unexpected shapes: n_in %d out %d ws %zu (need %zu)\n", n_in, out_size, ws_size, (size_t)WS_END); grid = -1; return; }
        int dev = 0, cus = 0;
        if (hipGetDevice(&dev) != hipSuccess || hipDeviceGetAttribute(&cus, hipDeviceAttributeMultiprocessorCount, dev) != hipSuccess) { grid = -1; return; }
        if (hipFuncSetAttribute((const void*)mk_fwd, hipFuncAttributeMaxDynamicSharedMemorySize, LDS_BYTES) != hipSuccess) { fprintf(stderr, "kernel_launch: hipFuncSetAttribute failed\n"); grid = -1; return; }
        int per_cu = 0;
        if (hipOccupancyMaxActiveBlocksPerMultiprocessor(&per_cu, (const void*)mk_fwd, NTHREADS, LDS_BYTES) != hipSuccess || per_cu < 1) fprintf(stderr, "kernel_launch: occupancy query reports %d\n", per_cu);
        (void)hipGetLastError();
        grid = cus;
    }
    if (grid < 0) return;
    if (hipMemsetAsync((char*)d_ws + WS_CTL, 0, CTL_BYTES, stream) != hipSuccess) return;
    Args a{};
    for (int i = 0; i < 23; ++i) a.in[i] = (const float*)d_in[i];
    a.out = (float*)d_out; a.ws = (unsigned char*)d_ws;
#if MK_SPLIT
    for (int p = 0; p < N_PHASES; ++p) { a.ph_lo = p; a.ph_hi = p + 1; hipLaunchKernelGGL(mk_fwd, dim3(grid), dim3(NTHREADS), LDS_BYTES, stream, a); }
#else
    a.ph_lo = 0; a.ph_hi = N_PHASES;
    hipLaunchKernelGGL(mk_fwd, dim3(grid), dim3(NTHREADS), LDS_BYTES, stream, a);
#endif
}
```

```cpp
#include <hip/hip_runtime.h>
#include <cstdio>
#include <cstdint>
namespace pg8 {
#define PG8_LAS __attribute__((address_space(3)))
typedef unsigned short bf16_t;
typedef short bf16x8 __attribute__((ext_vector_type(8)));
typedef float f32x4 __attribute__((ext_vector_type(4)));
typedef unsigned u32x4 __attribute__((ext_vector_type(4)));
constexpr int BM = 256, BK = 64, HALF = 128, HTB = HALF * BK * 2  , STAGE_BYTES = 8 * HTB, NXCD = 8, WGM = 8;

__host__ __device__ __forceinline__ int lds_byte(int r, int c) { const int st = (r >> 4) * 2 + (c >> 5), rr = r & 15, cc = c & 31, ob = rr * 64 + cc * 2; return st * 1024 + (ob ^ (((ob >> 9) & 1) << 5)); }
__host__ __device__ __forceinline__ void stage_rc(int b, int& R, int& C) { const int st = b / 1024, sb = b % 1024, swz = sb ^ (((sb >> 9) & 1) << 5); R = (st >> 1) * 16 + swz / 64; C = (st & 1) * 32 + (swz % 64) / 2; }
__host__ __device__ __forceinline__ int perm32(int rho) { const int n = rho >> 4, i = rho & 15; return 8 * (i >> 2) + 4 * n + (i & 3); }

struct Unit { int pm, pn; };
struct Gemm { const bf16_t* A; const bf16_t* Bt; int M, N, K; };

struct StaticOrder {
    int nM, nN, nwg, G, c;
    __host__ __device__ void init(int M, int N, int G_, int c_) { nM = M / BM; nN = N / BM; nwg = nM * nN; G = G_; c = c_; }
    __host__ __device__ bool next(int i, Unit& u) const {
        const long L = (long)i * G + c; if (L >= nwg) return false;
        int wgid = (int)L; { const int q = nwg / NXCD, r = nwg % NXCD, xcd = wgid % NXCD, off = wgid / NXCD; wgid = (xcd < r ? xcd * (q + 1) : r * (q + 1) + (xcd - r) * q) + off; }
        const int nig = WGM * nN, gid = wgid / nig, fm = gid * WGM, gsz = (nM - fm) < WGM ? (nM - fm) : WGM;
        u.pm = fm + ((wgid % nig) % gsz); u.pn = (wgid % nig) / gsz; return true;
    }
    __device__ __forceinline__ void a_ready(const Unit&) const {}
    __device__ __forceinline__ void done(const Unit&) const {}
};

__device__ __forceinline__ unsigned cvt_pk_bf16(float lo, float hi) { unsigned r; asm volatile("v_cvt_pk_bf16_f32 %0, %1, %2" : "=v"(r) : "v"(lo), "v"(hi)); return r; }
typedef float f32x2 __attribute__((ext_vector_type(2)));
template <class Epi, class Sched, bool ALIGN_EPI = false, bool SP2 = false>
__device__ __forceinline__ void gemm_phase(PG8_LAS unsigned char* lds, const Gemm g, const Sched& S, const Epi& E, const int wid_in  ) {
    int lane_; asm volatile("v_mbcnt_lo_u32_b32 %0, -1, 0\n\tv_mbcnt_hi_u32_b32 %0, -1, %0" : "=v"(lane_));
    const int wid = wid_in, lane = lane_, tid = wid * 64 + lane, wr = wid >> 2, wc = wid & 3, fr = lane & 15, fq = lane >> 4;
    const int K = g.K, nt = K / BK;
    unsigned voffA[2], voffB[2];
#pragma unroll
    for (int i = 0; i < 2; ++i) { int R, C; stage_rc(tid * 16 + i * 8192, R, C); const int Rb = Epi::PERM ? ((R & ~31) + perm32(R & 31)) : R;
        voffA[i] = (unsigned)(R * K + C) * 2u; voffB[i] = (unsigned)(Rb * K + C) * 2u; }
    const size_t kstep = (size_t)(BK * 2);
    const size_t hstep = (size_t)HALF * K * 2;
    const size_t tstep = 2 * hstep;
    const unsigned ldsw = (unsigned)wid * 1024u;
    const int aoff = lds_byte(wr * 64 + fr, fq * 8), boff = lds_byte(wc * 32 + fr, fq * 8);
#define PG8_SA(b, h) (((b) * 2 + (h)) * HTB)
#define PG8_SB(b, h) ((4 + (b) * 2 + (h)) * HTB)
#define PG8_STAGE(bufoff, gbase, voff) do { _Pragma("unroll") for (int _i = 0; _i < 2; ++_i) \
        __builtin_amdgcn_global_load_lds((const unsigned*)((const char*)(gbase) + (voff)[_i]), (PG8_LAS unsigned*)(lds + (bufoff) + ldsw + _i * 8192), 16, 0, 0); } while (0)
#define PG8_LDA(dst, b, h) do { _Pragma("unroll") for (int m = 0; m < 4; ++m) _Pragma("unroll") for (int k = 0; k < 2; ++k) dst[m][k] = *(const PG8_LAS bf16x8*)(lds + PG8_SA(b, h) + aoff + m * 2048 + k * 1024); } while (0)
#define PG8_LDB(dst, b, h) do { _Pragma("unroll") for (int n = 0; n < 2; ++n) _Pragma("unroll") for (int k = 0; k < 2; ++k) dst[n][k] = *(const PG8_LAS bf16x8*)(lds + PG8_SB(b, h) + boff + n * 2048 + k * 1024); } while (0)
#define PG8_MMA(ai, bj, At, Bt) do { __builtin_amdgcn_s_setprio(1); _Pragma("unroll") for (int m = 0; m < 4; ++m) _Pragma("unroll") for (int n = 0; n < 2; ++n) _Pragma("unroll") for (int k = 0; k < 2; ++k) \
        acc[ai][bj][m][n] = __builtin_amdgcn_mfma_f32_16x16x32_bf16(Bt[n][k], At[m][k], acc[ai][bj][m][n], 0, 0, 0); __builtin_amdgcn_s_setprio(0); } while (0)
#define PG8_WAIT_V(n) asm volatile("s_waitcnt vmcnt(" #n ")" ::: "memory")
#define PG8_WAIT_L(n) asm volatile("s_waitcnt lgkmcnt(" #n ")" ::: "memory")
#define PG8_BAR __builtin_amdgcn_s_barrier()
#define PG8_SCHED __builtin_amdgcn_sched_barrier(0)
    Unit cur, nxt; int ui = 0;
    if (!S.next(0, cur)) return;
    f32x4 acc[2][2][4][2];
#pragma unroll
    for (int a = 0; a < 2; ++a)
#pragma unroll
        for (int b = 0; b < 2; ++b)
#pragma unroll
            for (int m = 0; m < 4; ++m)
#pragma unroll
                for (int n = 0; n < 2; ++n) acc[a][b][m][n] = (f32x4){0.f, 0.f, 0.f, 0.f};
    bf16x8 At[4][2], B0[2][2], B1[2][2];
    const char* cA = (const char*)g.A + (size_t)cur.pm * tstep; const char* cB = (const char*)g.Bt + (size_t)cur.pn * tstep;
    S.a_ready(cur);
    if constexpr (SP2) {
        PG8_STAGE(PG8_SB(0, 0), cB, voffB); PG8_STAGE(PG8_SB(0, 1), cB + hstep, voffB); PG8_STAGE(PG8_SA(0, 0), cA, voffA); PG8_STAGE(PG8_SA(0, 1), cA + hstep, voffA);
        if (wr == 1) PG8_BAR;
        PG8_WAIT_V(2); PG8_BAR;
        PG8_STAGE(PG8_SB(1, 0), cB + kstep, voffB); PG8_STAGE(PG8_SA(1, 0), cA + kstep, voffA); PG8_STAGE(PG8_SB(1, 1), cB + hstep + kstep, voffB);
        PG8_WAIT_V(6); PG8_BAR;
    } else {
        PG8_STAGE(PG8_SB(0, 0), cB, voffB); PG8_STAGE(PG8_SA(0, 0), cA, voffA); PG8_STAGE(PG8_SB(0, 1), cB + hstep, voffB); PG8_STAGE(PG8_SA(0, 1), cA + hstep, voffA);
        if (wr == 1) PG8_BAR;
        PG8_WAIT_V(4); PG8_BAR;
        PG8_STAGE(PG8_SB(1, 0), cB + kstep, voffB); PG8_STAGE(PG8_SA(1, 0), cA + kstep, voffA); PG8_STAGE(PG8_SB(1, 1), cB + hstep + kstep, voffB);
        PG8_WAIT_V(6); PG8_BAR;
    }
    for (;;) {
        const bool has_next = S.next(ui + 1, nxt);
        const char* nA = has_next ? (const char*)g.A + (size_t)nxt.pm * tstep : cA; const char* nB = has_next ? (const char*)g.Bt + (size_t)nxt.pn * tstep : cB;
        for (int t = 0; t < nt; t += 2) {
            const bool last = (t == nt - 2);
            const char* a1 = cA + (size_t)(t + 1) * kstep;
            const char* a2 = last ? nA : cA + (size_t)(t + 2) * kstep; const char* b2 = last ? nB : cB + (size_t)(t + 2) * kstep;
            const char* a3 = a2 + kstep; const char* b3 = b2 + kstep;
            if (last && has_next) S.a_ready(nxt);
            if constexpr (SP2) {
            PG8_LDB(B0, 0, 0); PG8_LDB(B1, 0, 1); PG8_SCHED; PG8_LDA(At, 0, 0); PG8_STAGE(PG8_SA(1, 1), a1 + hstep, voffA);
            PG8_WAIT_V(8); PG8_WAIT_L(0); PG8_BAR; PG8_MMA(0, 0, At, B0); PG8_MMA(0, 1, At, B1); PG8_BAR; PG8_SCHED;
            PG8_LDA(At, 0, 1); PG8_STAGE(PG8_SB(0, 0), b2, voffB); PG8_STAGE(PG8_SB(0, 1), b2 + hstep, voffB); PG8_STAGE(PG8_SA(0, 0), a2, voffA);
            PG8_WAIT_V(8); PG8_WAIT_L(0); PG8_BAR; PG8_MMA(1, 0, At, B0); PG8_MMA(1, 1, At, B1); PG8_BAR; PG8_SCHED;
            PG8_LDB(B0, 1, 0); PG8_LDB(B1, 1, 1); PG8_SCHED; PG8_LDA(At, 1, 0); PG8_STAGE(PG8_SA(0, 1), a2 + hstep, voffA);
            PG8_WAIT_V(8); PG8_WAIT_L(0); PG8_BAR; PG8_MMA(0, 0, At, B0); PG8_MMA(0, 1, At, B1); PG8_BAR; PG8_SCHED;
            PG8_LDA(At, 1, 1); PG8_STAGE(PG8_SB(1, 0), b3, voffB); PG8_STAGE(PG8_SB(1, 1), b3 + hstep, voffB); PG8_STAGE(PG8_SA(1, 0), a3, voffA);
            PG8_WAIT_V(8); PG8_WAIT_L(0); PG8_BAR; PG8_MMA(1, 0, At, B0); PG8_MMA(1, 1, At, B1); PG8_BAR; PG8_SCHED;
            } else {
            PG8_LDB(B0, 0, 0); PG8_SCHED; PG8_LDA(At, 0, 0); PG8_STAGE(PG8_SA(1, 1), a1 + hstep, voffA);
            PG8_WAIT_L(8); PG8_BAR; PG8_WAIT_L(0); PG8_MMA(0, 0, At, B0); PG8_BAR; PG8_SCHED;
            PG8_LDB(B1, 0, 1); PG8_STAGE(PG8_SB(0, 0), b2, voffB);
            PG8_BAR; PG8_WAIT_L(0); PG8_MMA(0, 1, At, B1); PG8_BAR;
            PG8_LDA(At, 0, 1); PG8_STAGE(PG8_SA(0, 0), a2, voffA);
            PG8_BAR; PG8_WAIT_L(0); PG8_MMA(1, 0, At, B0); PG8_BAR; PG8_SCHED;
            PG8_STAGE(PG8_SB(0, 1), b2 + hstep, voffB);
            PG8_WAIT_V(6); PG8_BAR; PG8_MMA(1, 1, At, B1); PG8_BAR;
            PG8_LDB(B0, 1, 0); PG8_SCHED; PG8_LDA(At, 1, 0); PG8_STAGE(PG8_SA(0, 1), a2 + hstep, voffA);
            PG8_WAIT_L(8); PG8_BAR; PG8_WAIT_L(0); PG8_MMA(0, 0, At, B0); PG8_BAR; PG8_SCHED;
            PG8_LDB(B1, 1, 1); PG8_STAGE(PG8_SB(1, 0), b3, voffB);
            PG8_BAR; PG8_WAIT_L(0); PG8_MMA(0, 1, At, B1); PG8_BAR;
            PG8_LDA(At, 1, 1); PG8_STAGE(PG8_SA(1, 0), a3, voffA);
            PG8_BAR; PG8_WAIT_L(0); PG8_MMA(1, 0, At, B0); PG8_BAR; PG8_SCHED;
            PG8_STAGE(PG8_SB(1, 1), b3 + hstep, voffB);
            PG8_WAIT_V(6); PG8_BAR; PG8_MMA(1, 1, At, B1); PG8_BAR;
            }
        }
        if constexpr (ALIGN_EPI) { if (wr == 0) PG8_BAR; }
        if constexpr (!Epi::AFTER_DRAIN) { E(acc, cur, wr, wc, fr, fq); S.done(cur); }
        if (!has_next) break;
#pragma unroll
        for (int a = 0; a < 2; ++a)
#pragma unroll
            for (int b = 0; b < 2; ++b)
#pragma unroll
                for (int m = 0; m < 4; ++m)
#pragma unroll
                    for (int n = 0; n < 2; ++n) acc[a][b][m][n] = (f32x4){0.f, 0.f, 0.f, 0.f};
        cur = nxt; cA = nA; cB = nB; ++ui;
        if constexpr (ALIGN_EPI) { if (wr == 1) PG8_BAR; }
    }
    PG8_WAIT_V(0);
    if constexpr (!ALIGN_EPI) { if (wr == 0) PG8_BAR; }
    PG8_BAR;
    if constexpr (Epi::AFTER_DRAIN) { E.fused(acc, cur, wr, wc, fr, fq, lds, wid, lane); S.done(cur); }
#undef PG8_SA
#undef PG8_SB
#undef PG8_STAGE
#undef PG8_LDA
#undef PG8_LDB
#undef PG8_MMA
#undef PG8_WAIT_V
#undef PG8_WAIT_L
#undef PG8_BAR
#undef PG8_SCHED
}
}

#define LAS __attribute__((address_space(3)))
#define GAS __attribute__((address_space(1)))
typedef unsigned short bf16_t;
typedef short bf16x8 __attribute__((ext_vector_type(8)));
typedef short s16x4 __attribute__((ext_vector_type(4)));
typedef float f32x4 __attribute__((ext_vector_type(4)));
typedef float f32x16 __attribute__((ext_vector_type(16)));
typedef unsigned u32x4 __attribute__((ext_vector_type(4)));
typedef unsigned u32x2 __attribute__((ext_vector_type(2)));
typedef GAS unsigned gu32;

constexpr int DM = 1024, NBATCH = 8, SEQ = 8192, DEPTH = 4, DBATCH = 32, DSEQ = 64, PAST = 2048, LA = 512, DFF = 4096;
constexpr int TP = NBATCH * SEQ, TSAMP = DBATCH * DSEQ, T = TP + TSAMP;
constexpr int EA = T + DBATCH * LA, EC = T + DBATCH * PAST;
constexpr int NIN = 2304, INC = 2112;
constexpr float EPS = 1e-6f, LOG2E = 1.4426950408889634f, LN2 = 0.6931471805599453f;
constexpr int NWAVES = 8, NTHREADS = 512;

constexpr long OFF_Y = 0;
constexpr long OFF_PAK = (long)T * DM;
constexpr long SZ_PA = (long)DEPTH * NBATCH * LA * 256;
constexpr long OFF_PAV = OFF_PAK + SZ_PA;
constexpr long OFF_PCKV = OFF_PAV + SZ_PA;
constexpr long SZ_P256 = (long)DEPTH * TP * 256;
constexpr long OFF_PKR = OFF_PCKV + SZ_P256;
constexpr long OFF_PSBK = OFF_PKR + (long)DEPTH * TP * 64;
constexpr long OFF_PSBV = OFF_PSBK + SZ_P256;
constexpr long OFF_SAK = OFF_PSBV + SZ_P256;
constexpr long SZ_SA = (long)DEPTH * DBATCH * LA * 256;
constexpr long OFF_SAV = OFF_SAK + SZ_SA;
constexpr long OFF_SCKV = OFF_SAV + SZ_SA;
constexpr long SZ_S256 = (long)DEPTH * TSAMP * 256;
constexpr long OFF_SKR = OFF_SCKV + SZ_S256;
constexpr long OFF_SSBK = OFF_SKR + (long)DEPTH * TSAMP * 64;
constexpr long OFF_SSBV = OFF_SSBK + SZ_S256;
constexpr long OUT_TOTAL = OFF_SSBV + SZ_S256;
static_assert(OUT_TOTAL == 336068608L, "d_out map");

constexpr size_t WS_CTL = 0, CTL_BYTES = 1u << 20;
constexpr size_t WS_ROPE = WS_CTL + CTL_BYTES;
constexpr size_t WS_WIN = WS_ROPE + (size_t)8192 * 32 * 8;
constexpr size_t WS_WUQ = WS_WIN + (size_t)DEPTH * NIN * DM * 2;
constexpr size_t WS_WUKV = WS_WUQ + (size_t)DEPTH * 768 * 256 * 2;
constexpr size_t WS_WOUT = WS_WUKV + (size_t)DEPTH * 1024 * 256 * 2;
constexpr size_t WS_WUP = WS_WOUT + (size_t)DEPTH * DM * DM * 2;
constexpr size_t WS_WDN = WS_WUP + (size_t)DEPTH * DFF * DM * 2;
constexpr size_t WS_X = WS_WDN + (size_t)DEPTH * DFF * DM * 2;
constexpr size_t WS_SSQA = WS_X + (size_t)T * DM * 2;
constexpr size_t WS_SSQB = WS_SSQA + (size_t)T * 64;
constexpr size_t WS_ACT = WS_SSQB + (size_t)T * 64;
constexpr size_t WS_QA = WS_ACT;
constexpr size_t WS_KA = WS_QA + (size_t)T * 512;
constexpr size_t WS_VA = WS_KA + (size_t)EA * 512;
constexpr size_t WS_CQN = WS_VA + (size_t)EA * 512;
constexpr size_t WS_CKVN = WS_CQN + (size_t)T * 512;
constexpr size_t WS_KR = WS_CKVN + (size_t)EC * 512;
constexpr size_t WS_QC = WS_KR + (size_t)EC * 128;
constexpr size_t WS_KC = WS_QC + (size_t)T * 512;
constexpr size_t WS_VC = WS_KC + (size_t)EC * 512;
constexpr size_t WS_QM = WS_VC + (size_t)EC * 512;
constexpr size_t WS_KN = WS_QM + (size_t)T * 1536;
constexpr size_t WS_VM = WS_KN + (size_t)EC * 1024;
constexpr size_t WS_O = WS_VM + (size_t)EC * 1024;
constexpr size_t WS_ACT_END = WS_O + (size_t)T * DM * 2;
constexpr size_t WS_U = WS_ACT;
constexpr size_t WS_U_END = WS_U + (size_t)T * DFF * 2;
constexpr size_t WS_END = WS_ACT_END > WS_U_END ? WS_ACT_END : WS_U_END;
static_assert(WS_END < 1400000000ull, "d_ws map must stay below the guaranteed workspace size");
constexpr int CW_BAR = 4096;
constexpr int CW_QUEUE = 16384;

constexpr int LDS_XCH = 131072;
constexpr int LDS_MISC = LDS_XCH + 4096;
constexpr int LDS_BYTES = 147456;

__device__ __forceinline__ unsigned pk2(float lo, float hi) {
    typedef float f2_t __attribute__((ext_vector_type(2))); typedef __bf16 b2_t __attribute__((ext_vector_type(2)));
    f2_t v = {lo, hi}; b2_t b = __builtin_convertvector(v, b2_t); return __builtin_bit_cast(unsigned, b); }
__device__ __forceinline__ float bf_lo(unsigned w) { return __uint_as_float(w << 16); }
__device__ __forceinline__ float bf_hi(unsigned w) { return __uint_as_float(w & 0xffff0000u); }
__device__ __forceinline__ u32x2 pk4(f32x4 v) { u32x2 r; r.x = pk2(v.x, v.y); r.y = pk2(v.z, v.w); return r; }
__device__ __forceinline__ float sq4(f32x4 v) { return (v.x * v.x + v.y * v.y) + (v.z * v.z + v.w * v.w); }
#define LDS_WAIT() asm volatile("s_waitcnt lgkmcnt(0)" ::: "memory")
__device__ __forceinline__ int fresh_lane() { int l; asm volatile("v_mbcnt_lo_u32_b32 %0, -1, 0\n\tv_mbcnt_hi_u32_b32 %0, -1, %0" : "=v"(l)); return l; }
#define VM_WAIT() asm volatile("s_waitcnt vmcnt(0)" ::: "memory")

#define XB_TMO      128
#define XB_XCNT(j)  (256  + 64 * (j))
#define XB_XSUB(j)  (1280 + 64 * (j))
#define XB_XGEN(j)  (2304 + 64 * (j))
#define XB_TOP      3328
#define XB_TOPGEN   3392
#define XCD_BAR_WORDS 3456
#define XB_SPIN_CAP (1u << 22)
__device__ __forceinline__ unsigned xb_ld(unsigned* p)              { return __hip_atomic_load(p, __ATOMIC_RELAXED, __HIP_MEMORY_SCOPE_AGENT); }
__device__ __forceinline__ unsigned xb_add(unsigned* p, unsigned v) { return __hip_atomic_fetch_add(p, v, __ATOMIC_RELAXED, __HIP_MEMORY_SCOPE_AGENT); }
__device__ __forceinline__ unsigned xb_xcc_id() { return (unsigned)__builtin_amdgcn_s_getreg((3 << 11) | 20) & 0xFu; }
#define XB_SPIN(cond, bar) do { unsigned _sp = 0; while (cond) { __builtin_amdgcn_s_sleep(1); \
    if ((++_sp & 255u) == 0u) { if (xb_ld(&(bar)[XB_TMO])) break; if (_sp > XB_SPIN_CAP) { atomicAdd(&(bar)[XB_TMO], 1u); break; } } } } while (0)
struct XcdBarrier { unsigned* bar; unsigned x; volatile LAS unsigned* st; };
__device__ __forceinline__ XcdBarrier xcd_barrier_post(unsigned* bar, volatile LAS unsigned* st, bool thread0) {
    XcdBarrier b; b.bar = bar; b.x = xb_xcc_id(); b.st = st;
    if (thread0) (void)xb_add(&bar[XB_XCNT(b.x)], 1u);
    return b;
}
__device__ __forceinline__ void xcd_barrier_complete(unsigned* bar, unsigned x, unsigned& nloc, unsigned& nx) {
    const unsigned G = gridDim.x * gridDim.y * gridDim.z;
    unsigned sum, cnt, mine, sp = 0u;
    for (;;) {
        sum = 0u; cnt = 0u; mine = 0u;
#pragma unroll
        for (unsigned j = 0; j < 16; ++j) { const unsigned c = xb_ld(&bar[XB_XCNT(j)]); sum += c; cnt += (c > 0u) ? 1u : 0u; mine = (j == x) ? c : mine; }
        if (sum == G) break;
        __builtin_amdgcn_s_sleep(1);
        if ((++sp & 255u) == 0u) { if (xb_ld(&bar[XB_TMO])) break; if (sp > XB_SPIN_CAP) { atomicAdd(&bar[XB_TMO], 1u); break; } }
    }
    nloc = mine > 0u ? mine : 1u; nx = cnt > 0u ? cnt : 1u;
}
__device__ __forceinline__ void xcd_barrier(const XcdBarrier& b, bool thread0  ) {
    asm volatile("s_waitcnt vmcnt(0)" ::: "memory");
    __syncthreads();
    if (thread0) {
        unsigned* bar = b.bar;
        __builtin_amdgcn_s_waitcnt(0);
        unsigned nloc = b.st[0], nx = b.st[1];
        if (nloc == 0u) { xcd_barrier_complete(bar, b.x, nloc, nx); b.st[0] = nloc; b.st[1] = nx; }
        const unsigned old = xb_add(&bar[XB_XSUB(b.x)], 1u);
        const unsigned gen = old / nloc;
        if (old + 1u == (gen + 1u) * nloc) {
            __builtin_amdgcn_fence(__ATOMIC_RELEASE, "agent");
            asm volatile("s_waitcnt vmcnt(0)" ::: "memory");
            const unsigned og = xb_add(&bar[XB_TOP], 1u);
            const unsigned tg = og / nx;
            if (og + 1u == (tg + 1u) * nx) xb_add(&bar[XB_TOPGEN], 1u);
            else XB_SPIN(xb_ld(&bar[XB_TOPGEN]) == tg, bar);
            __builtin_amdgcn_fence(__ATOMIC_ACQUIRE, "agent");
            xb_add(&bar[XB_XGEN(b.x)], 1u);
            asm volatile("s_waitcnt vmcnt(0)" ::: "memory");
        } else {
            XB_SPIN(xb_ld(&bar[XB_XGEN(b.x)]) == gen, bar);
            __builtin_amdgcn_fence(__ATOMIC_ACQUIRE, "agent");
            asm volatile("s_waitcnt vmcnt(0)" ::: "memory");
        }
    }
    __syncthreads();
}

struct Args { const float* in[23]; float* out; unsigned char* ws; int ph_lo, ph_hi; };
struct Ctx {
    LAS unsigned char* lds;
    int tid, lane, wave, G, gw, ngw, bid;
    const Args* a;
    unsigned long long ws_, out_;
};
#define CIN(k) (C.a->in[k])
#define COUT ((float*)C.out_)
#define CWS ((unsigned char*)C.ws_)
#define WSP(T_, off) ((T_*)(CWS + (off)))

__device__ __forceinline__ float row_rs(const float* ssq, int row, int fq) {
    const f32x4 p = *(const f32x4*)(ssq + (size_t)row * 16 + 4 * fq);
    float s = (p.x + p.y) + (p.z + p.w);
    s += __shfl_xor(s, 16); s += __shfl_xor(s, 32);
    return rsqrtf(s * (1.0f / DM) + EPS);
}
__device__ __forceinline__ unsigned out_row_boff(int kind, int l, int r, bool& valid) {
    valid = true;
    if (r < TP) {
        const int b = r >> 13, t = r & (SEQ - 1);
        if (kind <= 1) { valid = t >= SEQ - LA; return (unsigned)((kind == 0 ? OFF_PAK : OFF_PAV) * 4) + (unsigned)((l * NBATCH + b) * LA + (t - (SEQ - LA))) * 1024u; }
        if (kind == 2) return (unsigned)(OFF_PCKV * 4) + (unsigned)(l * TP + r) * 1024u;
        if (kind == 3) return (unsigned)(OFF_PKR * 4) + (unsigned)(l * TP + r) * 256u;
        return (unsigned)((kind == 4 ? OFF_PSBK : OFF_PSBV) * 4) + (unsigned)(l * TP + r) * 1024u;
    } else {
        const int rs = r - TP, b = rs >> 6, t = rs & 63;
        if (kind <= 1) return (unsigned)((kind == 0 ? OFF_SAK : OFF_SAV) * 4) + (unsigned)((l * DBATCH + b) * LA + (LA - DSEQ) + t) * 1024u;
        if (kind == 2) return (unsigned)(OFF_SCKV * 4) + (unsigned)(l * TSAMP + rs) * 1024u;
        if (kind == 3) return (unsigned)(OFF_SKR * 4) + (unsigned)(l * TSAMP + rs) * 256u;
        return (unsigned)((kind == 4 ? OFF_SSBK : OFF_SSBV) * 4) + (unsigned)(l * TSAMP + rs) * 1024u;
    }
}
__device__ __forceinline__ int row_pos(int r) { return r < TP ? (r & (SEQ - 1)) : PAST + ((r - TP) & 63); }
static_assert(OUT_TOTAL * 4 < (1ll << 32) && WS_END < (1ull << 32), "32-bit byte offsets from the two base pointers");
#define ST8(base, boff, v)  (*(u32x2*)((char*)(base) + (boff)) = (v))
#define ST16F(base, boff, v) (*(f32x4*)((char*)(base) + (boff)) = (v))
#define LD16F(base, boff) (*(const f32x4*)((const char*)(base) + (boff)))


struct EpiIn {
    static constexpr bool PERM = false, AFTER_DRAIN = false;
    unsigned char* ws; float* out; int l; const float *g_cq, *g_ckv; LAS float* xch;
    __device__ __forceinline__ void operator()(const f32x4 (&acc)[2][2][4][2], const pg8::Unit& u, int wr, int wc, int fr, int fq) const {
        const int row0 = u.pm * 256 + wr * 64 + fr, t = u.pn, cl = wc * 32 + 4 * fq;
        float rs[2][4];
#pragma unroll
        for (int ai = 0; ai < 2; ++ai)
#pragma unroll
            for (int m = 0; m < 4; ++m) rs[ai][m] = row_rs((const float*)(ws + WS_SSQA), row0 + ai * 128 + m * 16, fq);
        if (t == 0 || t == 5) {
            const unsigned b0 = (unsigned)((t == 0) ? WS_QA : WS_QC) + (unsigned)(row0 * 256 + cl) * 2u;
#pragma unroll
            for (int ai = 0; ai < 2; ++ai)
#pragma unroll
                for (int m = 0; m < 4; ++m) { const unsigned ro = b0 + (unsigned)(ai * 128 + m * 16) * 512u; const float s = rs[ai][m];
#pragma unroll
                    for (int bj = 0; bj < 2; ++bj)
#pragma unroll
                        for (int n = 0; n < 2; ++n) ST8(ws, ro + bj * 256 + n * 32, pk4(acc[ai][bj][m][n] * s));
                    asm volatile("" ::: "memory"); }
        } else if (t == 1 || t == 2 || t == 6 || t == 7) {
            const unsigned b0 = (unsigned)((t == 1) ? WS_KA : (t == 2) ? WS_VA : (t == 6) ? WS_KC : WS_VC) + (unsigned)(row0 * 256 + cl) * 2u; const int kind = (t == 1) ? 0 : (t == 2) ? 1 : (t == 6) ? 4 : 5;
#pragma unroll
            for (int ai = 0; ai < 2; ++ai)
#pragma unroll
                for (int m = 0; m < 4; ++m) { const int row = row0 + ai * 128 + m * 16; const unsigned ro = b0 + (unsigned)(ai * 128 + m * 16) * 512u; const float s = rs[ai][m];
                    bool hasf; const unsigned fo = out_row_boff(kind, l, row, hasf) + (unsigned)cl * 4u;
#pragma unroll
                    for (int bj = 0; bj < 2; ++bj)
#pragma unroll
                        for (int n = 0; n < 2; ++n) { const f32x4 v = acc[ai][bj][m][n] * s; ST8(ws, ro + bj * 256 + n * 32, pk4(v));
                            if (hasf) ST16F(out, fo + bj * 512 + n * 64, v); }
                    asm volatile("" ::: "memory"); }
        } else if (t == 3 || t == 4) {
#pragma unroll
            for (int ai = 0; ai < 2; ++ai)
#pragma unroll
                for (int m = 0; m < 4; ++m) { float s = 0.f;
#pragma unroll
                    for (int bj = 0; bj < 2; ++bj)
#pragma unroll
                        for (int n = 0; n < 2; ++n) s += sq4(acc[ai][bj][m][n]);
                    s *= rs[ai][m] * rs[ai][m]; s += __shfl_xor(s, 16); s += __shfl_xor(s, 32);
                    if (fq == 0) xch[(ai * 128 + wr * 64 + m * 16 + fr) * 4 + wc] = s; }
            LDS_WAIT(); __builtin_amdgcn_s_barrier(); asm volatile("" ::: "memory");
            const float* g = (t == 3) ? g_cq : g_ckv;
            const unsigned b0 = (unsigned)((t == 3) ? WS_CQN : WS_CKVN) + (unsigned)(row0 * 256 + cl) * 2u;
            f32x4 gv[2][2];
#pragma unroll
            for (int bj = 0; bj < 2; ++bj)
#pragma unroll
                for (int n = 0; n < 2; ++n) gv[bj][n] = *(const f32x4*)(g + cl + bj * 128 + n * 16);
#pragma unroll
            for (int ai = 0; ai < 2; ++ai)
#pragma unroll
                for (int m = 0; m < 4; ++m) { const int row = row0 + ai * 128 + m * 16; const unsigned ro = b0 + (unsigned)(ai * 128 + m * 16) * 512u;
                    const f32x4 p = *(const LAS f32x4*)(xch + (ai * 128 + wr * 64 + m * 16 + fr) * 4);
                    const float tot = (p.x + p.y) + (p.z + p.w), s = rs[ai][m] * rsqrtf(tot * (1.0f / 256.0f) + EPS);
                    bool hasf; const unsigned fo = out_row_boff(2, l, row, hasf) + (unsigned)cl * 4u;
#pragma unroll
                    for (int bj = 0; bj < 2; ++bj)
#pragma unroll
                        for (int n = 0; n < 2; ++n) { const f32x4 v = acc[ai][bj][m][n] * s * gv[bj][n]; ST8(ws, ro + bj * 256 + n * 32, pk4(v));
                            if (t == 4) ST16F(out, fo + bj * 512 + n * 64, v); }
                    asm volatile("" ::: "memory"); }
        } else {
            if (wc < 2) {
#pragma unroll
                for (int ai = 0; ai < 2; ++ai)
#pragma unroll
                    for (int m = 0; m < 4; ++m) { const int row = row0 + ai * 128 + m * 16; const float s = rs[ai][m];
                        const unsigned tb = (unsigned)WS_ROPE + (unsigned)(row_pos(row) * 32 + 16 * wc + 4 * fq) * 8u;
                        const f32x4 c01 = LD16F(ws, tb), c23 = LD16F(ws, tb + 16);
                        const f32x4 x1 = acc[ai][0][m][0] * s, x2 = acc[ai][0][m][1] * s;
                        const f32x4 o1 = {x1.x * c01.x - x2.x * c01.y, x1.y * c01.z - x2.y * c01.w, x1.z * c23.x - x2.z * c23.y, x1.w * c23.z - x2.w * c23.w};
                        const f32x4 o2 = {x1.x * c01.y + x2.x * c01.x, x1.y * c01.w + x2.y * c01.z, x1.z * c23.y + x2.z * c23.x, x1.w * c23.w + x2.w * c23.z};
                        const unsigned ro = (unsigned)WS_KR + (unsigned)(row * 64 + 32 * wc + 4 * fq) * 2u; ST8(ws, ro, pk4(o1)); ST8(ws, ro + 32, pk4(o2));
                        bool hasf; const unsigned fo = out_row_boff(3, l, row, hasf) + (unsigned)(16 * wc + 4 * fq) * 4u;
                        ST16F(out, fo, o1); ST16F(out, fo + 128, o2);
                        asm volatile("" ::: "memory"); }
            }
        }
    }
};

struct EpiQup {
    static constexpr bool PERM = false, AFTER_DRAIN = false;
    unsigned char* ws;
    __device__ __forceinline__ void operator()(const f32x4 (&acc)[2][2][4][2], const pg8::Unit& u, int wr, int wc, int fr, int fq) const {
        const int row0 = u.pm * 256 + wr * 64 + fr;
        const int c00 = u.pn * 256 + wc * 32, e00 = c00 % 192, c01_ = c00 + 128, e01 = c01_ % 192;
#pragma unroll
        for (int ai = 0; ai < 2; ++ai)
#pragma unroll
            for (int m = 0; m < 4; ++m) { const int row = row0 + ai * 128 + m * 16; const unsigned ro = (unsigned)WS_QM + (unsigned)(row * 768 + 4 * fq) * 2u; const int pos = row_pos(row);
#pragma unroll
                for (int bj = 0; bj < 2; ++bj) { const int c0 = bj ? c01_ : c00, e0 = bj ? e01 : e00;
                    if (e0 >= 128) {
                        const unsigned tb = (unsigned)WS_ROPE + (unsigned)(pos * 32 + 16 * ((e0 - 128) >> 5) + 4 * fq) * 8u;
                        const f32x4 c01 = LD16F(ws, tb), c23 = LD16F(ws, tb + 16);
                        const f32x4 x1 = acc[ai][bj][m][0], x2 = acc[ai][bj][m][1];
                        const f32x4 o1 = {x1.x * c01.x - x2.x * c01.y, x1.y * c01.z - x2.y * c01.w, x1.z * c23.x - x2.z * c23.y, x1.w * c23.z - x2.w * c23.w};
                        const f32x4 o2 = {x1.x * c01.y + x2.x * c01.x, x1.y * c01.w + x2.y * c01.z, x1.z * c23.y + x2.z * c23.x, x1.w * c23.w + x2.w * c23.z};
                        ST8(ws, ro + c0 * 2, pk4(o1)); ST8(ws, ro + c0 * 2 + 32, pk4(o2));
                    } else {
                        ST8(ws, ro + c0 * 2, pk4(acc[ai][bj][m][0])); ST8(ws, ro + c0 * 2 + 32, pk4(acc[ai][bj][m][1]));
                    } }
                asm volatile("" ::: "memory"); }
    }
};
struct EpiKVup {
    static constexpr bool PERM = false, AFTER_DRAIN = false;
    unsigned char* ws;
    __device__ __forceinline__ void operator()(const f32x4 (&acc)[2][2][4][2], const pg8::Unit& u, int wr, int wc, int fr, int fq) const {
        const unsigned off0 = ((unsigned)(u.pm * 256 + wr * 64 + fr) * 512u + (unsigned)(u.pn * 128 + wc * 32 + 4 * fq)) * 2u;
#pragma unroll
        for (int ai = 0; ai < 2; ++ai)
#pragma unroll
            for (int m = 0; m < 4; ++m) { const unsigned ro = off0 + (unsigned)(ai * 128 + m * 16) * 1024u;
#pragma unroll
                for (int n = 0; n < 2; ++n) { ST8(ws, (unsigned)WS_KN + ro + n * 32, pk4(acc[ai][0][m][n])); ST8(ws, (unsigned)WS_VM + ro + n * 32, pk4(acc[ai][1][m][n])); }
                asm volatile("" ::: "memory"); }
    }
};
struct EpiResid {
    static constexpr bool PERM = false, AFTER_DRAIN = false;
    unsigned char* ws; unsigned ssq_off;
    __device__ __forceinline__ void operator()(const f32x4 (&acc)[2][2][4][2], const pg8::Unit& u, int wr, int wc, int fr, int fq) const {
        const int row0 = u.pm * 256 + wr * 64 + fr, cl = u.pn * 256 + wc * 32 + 4 * fq;
#pragma unroll
        for (int ai = 0; ai < 2; ++ai)
#pragma unroll
            for (int m = 0; m < 4; ++m) { const int row = row0 + ai * 128 + m * 16; const unsigned ro = (unsigned)WS_X + (unsigned)(row * DM + cl) * 2u; float part = 0.f;
#pragma unroll
                for (int bj = 0; bj < 2; ++bj)
#pragma unroll
                    for (int n = 0; n < 2; ++n) { const u32x2 xb = *(const u32x2*)((const char*)ws + ro + bj * 256 + n * 32); const f32x4 a = acc[ai][bj][m][n];
                        const f32x4 v = {bf_lo(xb.x) + a.x, bf_hi(xb.x) + a.y, bf_lo(xb.y) + a.z, bf_hi(xb.y) + a.w};
                        const u32x2 w = pk4(v); ST8(ws, ro + bj * 256 + n * 32, w);
                        const f32x4 q = {bf_lo(w.x), bf_hi(w.x), bf_lo(w.y), bf_hi(w.y)}; part += sq4(q); }
                part += __shfl_xor(part, 16); part += __shfl_xor(part, 32);
                if (fq == 0) *(float*)((char*)ws + ssq_off + (unsigned)(row * 16 + 4 * u.pn + wc) * 4u) = part;
                asm volatile("" ::: "memory"); }
    }
};
struct EpiFfnUp {
    static constexpr bool PERM = true, AFTER_DRAIN = false;
    unsigned char* ws;
    __device__ __forceinline__ void operator()(const f32x4 (&acc)[2][2][4][2], const pg8::Unit& u, int wr, int wc, int fr, int fq) const {
        const int row0 = u.pm * 256 + wr * 64 + fr, cl = u.pn * 256 + wc * 32 + 8 * fq;
#pragma unroll
        for (int ai = 0; ai < 2; ++ai)
#pragma unroll
            for (int m = 0; m < 4; ++m) { const int row = row0 + ai * 128 + m * 16; const float s = row_rs((const float*)(ws + WS_SSQB), row, fq); const unsigned ro = (unsigned)WS_U + ((unsigned)row * DFF + (unsigned)cl) * 2u;
#pragma unroll
                for (int bj = 0; bj < 2; ++bj) { f32x4 v0 = acc[ai][bj][m][0] * s, v1 = acc[ai][bj][m][1] * s;
                    v0 = __builtin_elementwise_max(v0, (f32x4){0.f, 0.f, 0.f, 0.f}); v1 = __builtin_elementwise_max(v1, (f32x4){0.f, 0.f, 0.f, 0.f});
                    v0 = v0 * v0; v1 = v1 * v1;
                    u32x4 w; w.x = pk2(v0.x, v0.y); w.y = pk2(v0.z, v0.w); w.z = pk2(v1.x, v1.y); w.w = pk2(v1.z, v1.w);
                    *(u32x4*)((char*)ws + ro + bj * 256) = w; }
                asm volatile("" ::: "memory"); }
    }
};

template <class Map>
__device__ __forceinline__ void tr_item(const float* W, int K, int Nsrc, bf16_t* WT, int Ndst, const float* rowgain, LAS float* scr, int item, int lane, const Map& map) {
    const int nblk = Ndst / 32, kb = item / nblk, nb = item % nblk, k0 = 64 * kb, n0 = 32 * nb;
    float cs = 1.f; const int sc = map(n0 + (lane & 31), cs);
#pragma unroll 8
    for (int i = 0; i < 32; ++i) { const int kk = 2 * i + (lane >> 5); float v = 0.f;
        if (sc >= 0) { v = W[(size_t)(k0 + kk) * Nsrc + sc] * cs; if (rowgain) v *= rowgain[k0 + kk]; }
        scr[kk * 33 + (lane & 31)] = v; }
    LDS_WAIT(); asm volatile("" ::: "memory");
    const int c = lane & 7;
#pragma unroll
    for (int j = 0; j < 4; ++j) { const int n = (lane >> 3) + 8 * j; const LAS float* s = scr + (8 * c) * 33 + n;
        u32x4 o; o.x = pk2(s[0 * 33], s[1 * 33]); o.y = pk2(s[2 * 33], s[3 * 33]); o.z = pk2(s[4 * 33], s[5 * 33]); o.w = pk2(s[6 * 33], s[7 * 33]);
        *(u32x4*)(WT + (size_t)(n0 + n) * K + k0 + 8 * c) = o; }
    LDS_WAIT(); asm volatile("" ::: "memory");
}
struct MapIdent { __device__ __forceinline__ int operator()(int n, float& cs) const { cs = 1.f; return n; } };
struct MapWin { __device__ __forceinline__ int operator()(int n, float& cs) const {
    const int t = n >> 8, c = n & 255; cs = (t == 0) ? 0.125f * LOG2E : (t == 5) ? 0.125f : 1.f;
    if (t < 5) return n;
    if (t < 8) return 1344 + (n - 1280);
    if (c >= 64) return -1;
    return 1280 + 16 * (c >> 5) + (c & 15) + 32 * ((c >> 4) & 1); } };
struct MapWuq { __device__ __forceinline__ int operator()(int n, float& cs) const {
    cs = 0.07216878364870322f * LOG2E;
    const int h = n / 192, e = n % 192; if (e < 128) return n;
    const int p = e - 128; return h * 192 + 128 + 16 * (p >> 5) + (p & 15) + 32 * ((p >> 4) & 1); } };

__device__ __forceinline__ void prologue(const Ctx& C) {
    LAS float* scr = (LAS float*)(C.lds + C.wave * 16384);
    constexpr int I_IN = (DM / 64) * (NIN / 32), I_UQ = (256 / 64) * (768 / 32), I_UKV = (256 / 64) * (1024 / 32), I_OUT = (DM / 64) * (DM / 32), I_UP = (DM / 64) * (DFF / 32), I_DN = (DFF / 64) * (DM / 32);
    constexpr int I_L = I_IN + I_UQ + I_UKV + I_OUT + I_UP + I_DN;
    for (int it = C.gw; it < DEPTH * I_L; it += C.ngw) {
        const int l = it / I_L; int r = it % I_L;
        if (r < I_IN) { tr_item(CIN(9) + (size_t)l * DM * INC, DM, INC, WSP(bf16_t, WS_WIN) + (size_t)l * NIN * DM, NIN, CIN(8) + l * DM, scr, r, C.lane, MapWin()); continue; } r -= I_IN;
        if (r < I_UQ) { tr_item(CIN(12) + (size_t)l * 256 * 768, 256, 768, WSP(bf16_t, WS_WUQ) + (size_t)l * 768 * 256, 768, nullptr, scr, r, C.lane, MapWuq()); continue; } r -= I_UQ;
        if (r < I_UKV) { tr_item(CIN(13) + (size_t)l * 256 * 1024, 256, 1024, WSP(bf16_t, WS_WUKV) + (size_t)l * 1024 * 256, 1024, nullptr, scr, r, C.lane, MapIdent()); continue; } r -= I_UKV;
        if (r < I_OUT) { tr_item(CIN(18) + (size_t)l * DM * DM, DM, DM, WSP(bf16_t, WS_WOUT) + (size_t)l * DM * DM, DM, nullptr, scr, r, C.lane, MapIdent()); continue; } r -= I_OUT;
        if (r < I_UP) { tr_item(CIN(20) + (size_t)l * DM * DFF, DM, DFF, WSP(bf16_t, WS_WUP) + (size_t)l * DFF * DM, DFF, CIN(19) + l * DM, scr, r, C.lane, MapIdent()); continue; } r -= I_UP;
        tr_item(CIN(21) + (size_t)l * DFF * DM, DFF, DM, WSP(bf16_t, WS_WDN) + (size_t)l * DM * DFF, DM, nullptr, scr, r, C.lane, MapIdent());
    }
    {
        float* tab = WSP(float, WS_ROPE);
        for (int e = C.gw * 64 + C.lane; e < 8192 * 32; e += C.ngw * 64) {
            const int pos = e >> 5, i = e & 31;
            double inv = 1.0; for (int k = 0; k < i; ++k) inv *= 0.74989420933245582730;
            const float ang = (float)pos * (float)inv;
            const double a = (double)ang, n = __builtin_rint(a * 0.15915494309189533577), r = (a - n * 6.283185307179586232) - n * 2.449293598294706414e-16, r2 = r * r;
            double s = 1.0, c = 1.0;
#pragma unroll
            for (int k = 13; k >= 1; --k) { s = 1.0 - r2 * (1.0 / (double)((2 * k) * (2 * k + 1))) * s; c = 1.0 - r2 * (1.0 / (double)((2 * k - 1) * (2 * k))) * c; }
            tab[2 * e] = (float)c; tab[2 * e + 1] = (float)(r * s);
        }
    }
    {
        bf16_t* X = WSP(bf16_t, WS_X); float* ssq = WSP(float, WS_SSQA);
        for (int row = C.gw; row < T; row += C.ngw) {
            const float* xr = (row < TP) ? CIN(0) + (size_t)row * DM : CIN(1) + (size_t)(row - TP) * DM;
            f32x4 v[4]; u32x2 w[4]; float s = 0.f;
#pragma unroll
            for (int j = 0; j < 4; ++j) { v[j] = *(const f32x4*)(xr + 256 * j + 4 * C.lane); w[j] = pk4(v[j]);
                const f32x4 q = {bf_lo(w[j].x), bf_hi(w[j].x), bf_lo(w[j].y), bf_hi(w[j].y)}; s += sq4(q); }
#pragma unroll
            for (int o = 1; o < 64; o <<= 1) s += __shfl_xor(s, o);
#pragma unroll
            for (int j = 0; j < 4; ++j) *(u32x2*)(X + (size_t)row * DM + 256 * j + 4 * C.lane) = w[j];
            if (C.lane < 16) ssq[(size_t)row * 16 + C.lane] = (C.lane == 0) ? s : 0.f;
        }
    }
}

__device__ __forceinline__ void convert_caches(const Ctx& C, int l) {
    constexpr int SEGC = 524288;
    const int gt = C.gw * 64 + C.lane, ngt = C.ngw * 64;
    for (int ci = gt; ci < 15 * SEGC; ci += ngt) {
        const int seg = ci / SEGC; const size_t e0 = (size_t)(ci % SEGC) * 8;
        const float* src; bf16_t* dst; size_t eo = e0;
        if (seg < 2) { src = CIN(2 + seg) + (size_t)l * DBATCH * LA * 256; dst = WSP(bf16_t, seg == 0 ? WS_KA : WS_VA) + (size_t)T * 256; }
        else if (seg < 6) { eo = e0 + (size_t)(seg - 2) * 4194304; src = CIN(6) + (size_t)l * DBATCH * PAST * 256; dst = WSP(bf16_t, WS_KC) + (size_t)T * 256; }
        else if (seg < 10) { eo = e0 + (size_t)(seg - 6) * 4194304; src = CIN(7) + (size_t)l * DBATCH * PAST * 256; dst = WSP(bf16_t, WS_VC) + (size_t)T * 256; }
        else if (seg < 14) { eo = e0 + (size_t)(seg - 10) * 4194304; src = CIN(4) + (size_t)l * DBATCH * PAST * 256; dst = WSP(bf16_t, WS_CKVN) + (size_t)T * 256; }
        else { src = CIN(5) + (size_t)l * DBATCH * PAST * 64; dst = WSP(bf16_t, WS_KR) + (size_t)T * 64; }
        const f32x4 a = *(const f32x4*)(src + eo), b = *(const f32x4*)(src + eo + 4);
        u32x4 w; w.x = pk2(a.x, a.y); w.y = pk2(a.z, a.w); w.z = pk2(b.x, b.y); w.w = pk2(b.z, b.w);
        size_t edst = eo;
        if (seg == 14) { const int c = (int)(eo & 63); edst = (eo & ~(size_t)63) + 32 * ((c & 31) >> 4) + 16 * (c >> 5) + (c & 15); }
        *(u32x4*)(dst + edst) = w;
        if (seg < 2) { const int bb = (int)(e0 / (LA * 256)), s = (int)(e0 / 256) % LA, c = (int)(e0 % 256);
            if (s >= DSEQ) { float* o = COUT + (seg == 0 ? OFF_SAK : OFF_SAV) + ((long)((l * DBATCH + bb) * LA + s - DSEQ)) * 256 + c; *(f32x4*)o = a; *(f32x4*)(o + 4) = b; } }
    }
}

__device__ __forceinline__ void norm_mixer(const Ctx& C, int l) {
    bf16_t* O = WSP(bf16_t, WS_O);
    const int lane = C.lane; const bool isM = (lane >= 16 && lane < 48);
    const float* g = lane < 16 ? CIN(15) + l * 256 + 16 * lane : isM ? CIN(16) + l * 512 + 16 * (lane - 16) : CIN(17) + l * 256 + 16 * (lane - 48);
    f32x4 gv[4];
#pragma unroll
    for (int j = 0; j < 4; ++j) gv[j] = *(const f32x4*)(g + 4 * j);
    for (int row = C.gw; row < T; row += C.ngw) {
        bf16_t* rp = O + (size_t)row * DM + 16 * lane;
        const u32x4 w0 = *(const u32x4*)rp, w1 = *(const u32x4*)(rp + 8);
        f32x4 v[4] = {{bf_lo(w0.x), bf_hi(w0.x), bf_lo(w0.y), bf_hi(w0.y)}, {bf_lo(w0.z), bf_hi(w0.z), bf_lo(w0.w), bf_hi(w0.w)},
                      {bf_lo(w1.x), bf_hi(w1.x), bf_lo(w1.y), bf_hi(w1.y)}, {bf_lo(w1.z), bf_hi(w1.z), bf_lo(w1.w), bf_hi(w1.w)}};
        float s = (sq4(v[0]) + sq4(v[1])) + (sq4(v[2]) + sq4(v[3]));
        s += __shfl_xor(s, 1); s += __shfl_xor(s, 2); s += __shfl_xor(s, 4); s += __shfl_xor(s, 8);
        const float so = __shfl_xor(s, 48);
        const float rs = isM ? rsqrtf((s + so) * (1.0f / 512.0f) + EPS) : rsqrtf(s * (1.0f / 256.0f) + EPS);
#pragma unroll
        for (int j = 0; j < 4; ++j) v[j] = v[j] * rs * gv[j];
        u32x4 o0, o1; o0.x = pk2(v[0].x, v[0].y); o0.y = pk2(v[0].z, v[0].w); o0.z = pk2(v[1].x, v[1].y); o0.w = pk2(v[1].z, v[1].w);
        o1.x = pk2(v[2].x, v[2].y); o1.y = pk2(v[2].z, v[2].w); o1.z = pk2(v[3].x, v[3].y); o1.w = pk2(v[3].z, v[3].w);
        *(u32x4*)rp = o0; *(u32x4*)(rp + 8) = o1;
    }
}

__device__ __forceinline__ void final_norm(const Ctx& C) {
    const bf16_t* X = WSP(bf16_t, WS_X); const float* ssq = WSP(float, WS_SSQA); const float* g = CIN(22);
    for (int row = C.gw; row < T; row += C.ngw) {
        const f32x4 p0 = *(const f32x4*)(ssq + (size_t)row * 16), p1 = *(const f32x4*)(ssq + (size_t)row * 16 + 4), p2 = *(const f32x4*)(ssq + (size_t)row * 16 + 8), p3 = *(const f32x4*)(ssq + (size_t)row * 16 + 12);
        const float tot = ((p0.x + p0.y) + (p0.z + p0.w)) + ((p1.x + p1.y) + (p1.z + p1.w)) + ((p2.x + p2.y) + (p2.z + p2.w)) + ((p3.x + p3.y) + (p3.z + p3.w));
        const float rs = rsqrtf(tot * (1.0f / DM) + EPS);
#pragma unroll
        for (int j = 0; j < 2; ++j) { const int c = 512 * j + 8 * C.lane; const u32x4 w = *(const u32x4*)(X + (size_t)row * DM + c);
            const f32x4 g0 = *(const f32x4*)(g + c), g1 = *(const f32x4*)(g + c + 4);
            const f32x4 a = {bf_lo(w.x) * rs * g0.x, bf_hi(w.x) * rs * g0.y, bf_lo(w.y) * rs * g0.z, bf_hi(w.y) * rs * g0.w};
            const f32x4 b = {bf_lo(w.z) * rs * g1.x, bf_hi(w.z) * rs * g1.y, bf_lo(w.w) * rs * g1.z, bf_hi(w.w) * rs * g1.w};
            float* o = COUT + OFF_Y + (size_t)row * DM + c; *(f32x4*)o = a; *(f32x4*)(o + 4) = b; }
    }
}

struct AttnDesc { int qrow0, nact, cq0, cbase, ncache, nbase, head; };

#define MFMA32(a, b, c) __builtin_amdgcn_mfma_f32_32x32x16_bf16((a), (b), (c), 0, 0, 0)
__device__ __forceinline__ s16x4 tr16(const LAS unsigned char* p) {
    typedef short v4i16_t __attribute__((ext_vector_type(4)));
    return __builtin_bit_cast(s16x4, __builtin_amdgcn_ds_read_tr16_b64_v4i16((LAS v4i16_t*)p)); }
__device__ __forceinline__ bf16x8 pack8(const f32x16& x, int s) {
    u32x4 p; p.x = pk2(x[8 * s + 0], x[8 * s + 1]); p.y = pk2(x[8 * s + 2], x[8 * s + 3]); p.z = pk2(x[8 * s + 4], x[8 * s + 5]); p.w = pk2(x[8 * s + 6], x[8 * s + 7]);
    return __builtin_bit_cast(bf16x8, p); }
__device__ __forceinline__ float half_max(float m) { auto rr = __builtin_amdgcn_permlane32_swap(__float_as_uint(m), __float_as_uint(m), false, false);
    return fmaxf(__uint_as_float(rr[0]), __uint_as_float(rr[1])); }
__device__ __forceinline__ float half_sum(float m) { auto rr = __builtin_amdgcn_permlane32_swap(__float_as_uint(m), __float_as_uint(m), false, false);
    return __uint_as_float(rr[0]) + __uint_as_float(rr[1]); }

template <int KIND>
__device__ __forceinline__ void attn_unit(const Ctx& C, const AttnDesc d, const bf16_t* Q, const bf16_t* K, const bf16_t* Kr, const bf16_t* V, bf16_t* O, const float* biasg) {
    constexpr int DQK = (KIND == 0) ? 192 : 64, DV = (KIND == 0) ? 128 : 64, NKS = DQK / 16, NDB = DV / 32;
    constexpr int QP = (KIND == 0) ? 768 : 256, KP = (KIND == 0) ? 512 : 256;
    constexpr int KSTR = (KIND == 0) ? 400 : 144, VSTR = (KIND == 0) ? 320 : 192;
    constexpr int STAGE = 64 * KSTR + 64 * VSTR, NP = (KIND == 0) ? 5 : 2;
    constexpr int LDS_TAB = 98304, LDS_FLAGS = LDS_MISC + 32;
    const int tid = C.tid, lane = C.lane, w = C.wave, r = lane & 31, hh = lane >> 5;
    const bool wact = w < d.nact;
    const int cw = d.cq0 + (w >> 1);
    const int ctop = d.cq0 + (d.nact == 8 ? 3 : 0);
    const int kmin = (KIND == 1) ? (d.cq0 > 8 ? d.cq0 - 8 : 0) : 0;
    const int nt = ctop - kmin + 1;
    const int qrow = d.qrow0 + 32 * w + r;
    bf16x8 qf[NKS];
    if (wact) {
#pragma unroll
        for (int ks = 0; ks < NKS; ++ks) qf[ks] = *(const bf16x8*)(Q + (size_t)qrow * QP + d.head * DQK + ks * 16 + hh * 8);
    } else {
#pragma unroll
        for (int ks = 0; ks < NKS; ++ks) qf[ks] = (bf16x8){0, 0, 0, 0, 0, 0, 0, 0};
    }
    if (KIND == 1) { if (tid < 192) ((LAS float*)(C.lds + LDS_TAB))[tid] = biasg[tid] * LOG2E; }
    f32x16 o[NDB];
#pragma unroll
    for (int db = 0; db < NDB; ++db)
#pragma unroll
        for (int i = 0; i < 16; ++i) o[db][i] = 0.f;
    float mrun = -1e30f, lsum = 0.f, Crun = 0.f; bool started = false;
    u32x4 st[NP];
#define kc_of(jt__) ((KIND == 2) ? (ctop - (jt__)) : (kmin + (jt__)))
#define STAGE_LOAD(jt_) do { const int kc_ = kc_of(jt_); const size_t rb_ = (size_t)(kc_ < d.ncache ? d.cbase + 64 * kc_ : d.nbase); \
        if (KIND == 0) { \
            _Pragma("unroll") for (int p_ = 0; p_ < 2; ++p_) { const int idx_ = p_ * 512 + tid; st[p_] = *(const u32x4*)(K + (rb_ + (idx_ >> 4)) * KP + d.head * 128 + (idx_ & 15) * 8); } \
            st[2] = *(const u32x4*)(Kr + (rb_ + (tid >> 3)) * 64 + (tid & 7) * 8); \
            _Pragma("unroll") for (int p_ = 0; p_ < 2; ++p_) { const int idx_ = p_ * 512 + tid; st[3 + p_] = *(const u32x4*)(V + (rb_ + (idx_ >> 4)) * KP + d.head * 128 + (idx_ & 15) * 8); } \
        } else { \
            st[0] = *(const u32x4*)(K + (rb_ + (tid >> 3)) * KP + d.head * 64 + (tid & 7) * 8); \
            st[1] = *(const u32x4*)(V + (rb_ + (tid >> 3)) * KP + d.head * 64 + (tid & 7) * 8); \
        } } while (0)
#define STAGE_STORE(buf_) do { LAS unsigned char* kb_ = C.lds + (buf_) * STAGE; LAS unsigned char* vb_ = kb_ + 64 * KSTR; \
        if (KIND == 0) { \
            _Pragma("unroll") for (int p_ = 0; p_ < 2; ++p_) { const int idx_ = p_ * 512 + tid; *(LAS u32x4*)(kb_ + (idx_ >> 4) * KSTR + (idx_ & 15) * 16) = st[p_]; } \
            *(LAS u32x4*)(kb_ + (tid >> 3) * KSTR + 256 + (tid & 7) * 16) = st[2]; \
            _Pragma("unroll") for (int p_ = 0; p_ < 2; ++p_) { const int idx_ = p_ * 512 + tid; *(LAS u32x4*)(vb_ + (idx_ >> 4) * VSTR + (idx_ & 15) * 16) = st[3 + p_]; } \
        } else { \
            *(LAS u32x4*)(kb_ + (tid >> 3) * KSTR + (tid & 7) * 16) = st[0]; \
            *(LAS u32x4*)(vb_ + (tid >> 3) * VSTR + (tid & 7) * 16) = st[1]; \
        } } while (0)
    STAGE_LOAD(0); STAGE_STORE(0);
    __syncthreads();
    const int q4 = (lane & 15) >> 2, p4 = lane & 3, blk = (lane >> 4) & 1;
    const int qin = 32 * (w & 1) + r;
    int buf = 0;
    for (int jt = 0; jt < nt; ++jt) {
        const bool more = jt + 1 < nt;
        if (more) STAGE_LOAD(jt + 1);
        const int kc = kc_of(jt);
        bool act = wact && kc <= cw;
        if (KIND == 1) act = act && (cw - kc <= 8);
        if (act) {
            const LAS unsigned char* Kb = C.lds + buf * STAGE; const LAS unsigned char* Vb = Kb + 64 * KSTR;
            f32x16 s0, s1;
#pragma unroll
            for (int i = 0; i < 16; ++i) { s0[i] = 0.f; s1[i] = 0.f; }
            const LAS unsigned char* kp0 = Kb + r * KSTR + hh * 16; const LAS unsigned char* kp1 = kp0 + 32 * KSTR;
            bf16x8 kA0 = *(const LAS bf16x8*)(kp0), kA1 = *(const LAS bf16x8*)(kp1), kB0, kB1;
            const LAS unsigned char* vp = Vb + (4 * hh + q4) * VSTR + (16 * blk + 4 * p4) * 2;
            s16x4 vA[NDB][2], vB[NDB][2];
#define VLD(s2_, buf_) do { _Pragma("unroll") for (int db_ = 0; db_ < NDB; ++db_) { buf_[db_][0] = tr16(vp + (16 * (s2_)) * VSTR + 64 * db_); buf_[db_][1] = tr16(vp + (16 * (s2_) + 8) * VSTR + 64 * db_); } } while (0)
#define VCAT(x_) ((bf16x8){x_[0][0], x_[0][1], x_[0][2], x_[0][3], x_[1][0], x_[1][1], x_[1][2], x_[1][3]})
#pragma unroll
            for (int ks = 0; ks < NKS; ks += 2) {
                kB0 = *(const LAS bf16x8*)(kp0 + (ks + 1) * 32); kB1 = *(const LAS bf16x8*)(kp1 + (ks + 1) * 32);
                s0 = MFMA32(kA0, qf[ks], s0); s1 = MFMA32(kA1, qf[ks], s1);
                __builtin_amdgcn_sched_barrier(0);
                if (ks + 2 < NKS) { kA0 = *(const LAS bf16x8*)(kp0 + (ks + 2) * 32); kA1 = *(const LAS bf16x8*)(kp1 + (ks + 2) * 32); }
                else VLD(0, vA);
                s0 = MFMA32(kB0, qf[ks + 1], s0); s1 = MFMA32(kB1, qf[ks + 1], s1);
                __builtin_amdgcn_sched_barrier(0);
            }
            if (KIND != 2) {
                if (KIND == 1) {
                    const LAS float* tab = (const LAS float*)(C.lds + LDS_TAB);
                    const int bc = kc - cw + 8;
                    if (bc <= 5) { const float cb = tab[191];
#pragma unroll
                        for (int i = 0; i < 16; ++i) { s0[i] += cb; s1[i] += cb; }
                    } else {
                        const int db0 = 64 * (8 - bc) + qin - 4 * hh;
#pragma unroll
                        for (int i = 0; i < 16; ++i) { const int d0 = db0 - ((i & 3) + 8 * (i >> 2)), d1 = d0 - 32;
                            s0[i] += tab[(d0 > 128 ? 128 : d0) + 63]; s1[i] += tab[(d1 > 128 ? 128 : d1) + 63]; }
                    }
                }
                float mx = fmaxf(s0[0], s1[0]);
#pragma unroll
                for (int i = 1; i < 16; ++i) mx = fmaxf(mx, fmaxf(s0[i], s1[i]));
                mx = half_max(mx);
                if (__any(mx > mrun + 8.0f)) {
                    const float mn = fmaxf(mrun, mx), alpha = __builtin_amdgcn_exp2f(mrun - mn); mrun = mn; lsum *= alpha;
#pragma unroll
                    for (int db = 0; db < NDB; ++db)
#pragma unroll
                        for (int i = 0; i < 16; ++i) o[db][i] *= alpha;
                }
                float ps = 0.f;
#pragma unroll
                for (int i = 0; i < 16; ++i) { s0[i] = __builtin_amdgcn_exp2f(s0[i] - mrun); s1[i] = __builtin_amdgcn_exp2f(s1[i] - mrun); ps += s0[i] + s1[i]; }
                lsum += ps;
            } else {
                started = true;
                const bool diag = (kc == cw);
#pragma unroll
                for (int kb = 1; kb >= 0; --kb) {
                    f32x16& sT = kb ? s1 : s0;
                    float lg[16], G[4], PG[4];
#pragma unroll
                    for (int i = 0; i < 16; ++i) { const float z = sT[i]; const bool valid = !diag || (32 * kb + (i & 3) + 8 * (i >> 2) + 4 * hh < qin);
                        const float sp = fmaxf(z, 0.f) + LN2 * __builtin_amdgcn_logf(1.0f + __builtin_amdgcn_exp2f(-fabsf(z) * LOG2E));
                        lg[i] = valid ? -sp : 0.f; sT[i] = valid ? z : -1e30f; }
#pragma unroll
                    for (int g = 0; g < 4; ++g) { G[g] = (lg[4 * g] + lg[4 * g + 1]) + (lg[4 * g + 2] + lg[4 * g + 3]); PG[g] = __shfl_xor(G[g], 32); }
                    float run = Crun;
#pragma unroll
                    for (int g = 3; g >= 0; --g) {
                        float cex = run + (hh == 0 ? PG[g] : 0.f);
#pragma unroll
                        for (int e = 3; e >= 0; --e) { const int i = 4 * g + e; const float arg = fminf(sT[i] + lg[i] + cex, 0.f);
                            cex += lg[i]; sT[i] = __builtin_amdgcn_exp2f(arg * LOG2E); }
                        run += G[g] + PG[g];
                    }
                    Crun = run;
                }
            }
            { VLD(1, vB); const bf16x8 pf = pack8(s0, 0);
#pragma unroll
              for (int db = 0; db < NDB; ++db) o[db] = MFMA32(VCAT(vA[db]), pf, o[db]);
              __builtin_amdgcn_sched_barrier(0); }
            { VLD(2, vA); const bf16x8 pf = pack8(s0, 1);
#pragma unroll
              for (int db = 0; db < NDB; ++db) o[db] = MFMA32(VCAT(vB[db]), pf, o[db]);
              __builtin_amdgcn_sched_barrier(0); }
            { VLD(3, vB); const bf16x8 pf = pack8(s1, 0);
#pragma unroll
              for (int db = 0; db < NDB; ++db) o[db] = MFMA32(VCAT(vA[db]), pf, o[db]);
              __builtin_amdgcn_sched_barrier(0); }
            { const bf16x8 pf = pack8(s1, 1);
#pragma unroll
              for (int db = 0; db < NDB; ++db) o[db] = MFMA32(VCAT(vB[db]), pf, o[db]); }
#undef VLD
#undef VCAT
        }
        if (more) STAGE_STORE(buf ^ 1);
        if (KIND == 2) {
            const bool done = !wact || (started && (__ballot(Crun > -104.0f) == 0ull));
            if (lane == 0) ((LAS unsigned*)(C.lds + LDS_FLAGS))[(jt & 1) * 8 + w] = done ? 1u : 0u;
        }
        __syncthreads();
        if (KIND == 2) {
            const LAS u32x4* fl = (const LAS u32x4*)(C.lds + LDS_FLAGS + (jt & 1) * 32);
            const u32x4 f0 = fl[0], f1 = fl[1];
            if ((f0.x & f0.y & f0.z & f0.w & f1.x & f1.y & f1.z & f1.w) != 0u) break;
        }
        buf ^= 1;
    }
#undef STAGE_LOAD
#undef STAGE_STORE
#undef kc_of
    if (wact) {
        float inv = 1.f;
        if (KIND != 2) { const float lt = half_sum(lsum); inv = 1.0f / lt; }
        bf16_t* op = O + (size_t)qrow * DM + d.head * DV;
#pragma unroll
        for (int db = 0; db < NDB; ++db)
#pragma unroll
            for (int g = 0; g < 4; ++g) { const f32x4 v = {o[db][4 * g] * inv, o[db][4 * g + 1] * inv, o[db][4 * g + 2] * inv, o[db][4 * g + 3] * inv};
                *(u32x2*)(op + 32 * db + 8 * g + 4 * hh) = pk4(v); }
    }
    __syncthreads();
}

constexpr int NU_ATT = 3456;
__device__ __forceinline__ void attn_phase(const Ctx& C, int l, int qslot) {
    gu32* head = (gu32*)(CWS + WS_CTL) + CW_QUEUE + 64 * qslot;
    LAS unsigned* bc = (LAS unsigned*)(C.lds + LDS_MISC + 16);
    const bf16_t *QA = WSP(bf16_t, WS_QA), *KA = WSP(bf16_t, WS_KA), *VA = WSP(bf16_t, WS_VA), *QC = WSP(bf16_t, WS_QC), *KC = WSP(bf16_t, WS_KC), *VC = WSP(bf16_t, WS_VC);
    const bf16_t *QM = WSP(bf16_t, WS_QM), *KN = WSP(bf16_t, WS_KN), *VM = WSP(bf16_t, WS_VM), *KR = WSP(bf16_t, WS_KR);
    bf16_t* O = WSP(bf16_t, WS_O);
    for (;;) {
        if (C.tid == 0) bc[0] = __hip_atomic_fetch_add(head, 1u, __ATOMIC_RELAXED, __HIP_MEMORY_SCOPE_AGENT);
        __syncthreads();
        const int u = (int)bc[0];
        __syncthreads();
        if (u >= NU_ATT) break;
        AttnDesc d;
        if (u < 1152) {
            if (u < 1024) { const int qb = 31 - (u >> 5), bh = u & 31, b = bh >> 2; d.head = bh & 3; d.qrow0 = b * SEQ + 256 * qb; d.nact = 8; d.cq0 = 4 * qb; d.cbase = b * SEQ; d.ncache = 1 << 20; d.nbase = 0; }
            else { const int i = u - 1024, b = i >> 2; d.head = i & 3; d.qrow0 = TP + 64 * b; d.nact = 2; d.cq0 = PAST / 64; d.cbase = T + b * PAST; d.ncache = PAST / 64; d.nbase = TP + 64 * b; }
            attn_unit<0>(C, d, QM, KN, KR, VM, O + 256, nullptr);
        } else if (u < 2304) {
            if (u < 2176) { const int i = u - 1152, g = 31 - (i >> 5), bh = i & 31, b = bh >> 2; d.head = bh & 3; d.qrow0 = b * SEQ + 256 * g; d.nact = 8; d.cq0 = 4 * g; d.cbase = b * SEQ; d.ncache = 1 << 20; d.nbase = 0; }
            else { const int i = u - 2176, b = i >> 2; d.head = i & 3; d.qrow0 = TP + 64 * b; d.nact = 2; d.cq0 = LA / 64; d.cbase = T + b * LA; d.ncache = LA / 64; d.nbase = TP + 64 * b; }
            attn_unit<1>(C, d, QA, KA, nullptr, VA, O, CIN(14) + (size_t)(l * 4 + d.head) * 192);
        } else {
            if (u < 3328) { const int i = u - 2304, qb = 31 - (i >> 5), bh = i & 31, b = bh >> 2; d.head = bh & 3; d.qrow0 = b * SEQ + 256 * qb; d.nact = 8; d.cq0 = 4 * qb; d.cbase = b * SEQ; d.ncache = 1 << 20; d.nbase = 0; }
            else { const int i = u - 3328, b = i >> 2; d.head = i & 3; d.qrow0 = TP + 64 * b; d.nact = 2; d.cq0 = PAST / 64; d.cbase = T + b * PAST; d.ncache = PAST / 64; d.nbase = TP + 64 * b; }
            attn_unit<2>(C, d, QC, KC, nullptr, VC, O + 768, nullptr);
        }
    }
}

constexpr int PH_PER_LAYER = 7, N_PHASES = 1 + DEPTH * PH_PER_LAYER + 1;

__global__ void __launch_bounds__(NTHREADS, 2) mk_fwd(Args args) {
    extern __shared__ __attribute__((aligned(16))) unsigned char lds_raw[];
    Ctx C;
    C.lds = (LAS unsigned char*)lds_raw;
    const int wave0 = __builtin_amdgcn_readfirstlane((int)threadIdx.x >> 6);
    C.wave = wave0; C.bid = blockIdx.x; C.lane = fresh_lane(); C.tid = C.wave * 64 + C.lane;
    C.G = gridDim.x; C.gw = blockIdx.x * NWAVES + C.wave; C.ngw = C.G * NWAVES;
    C.a = &args; C.ws_ = (unsigned long long)args.ws; C.out_ = (unsigned long long)args.out;
    for (int u = C.tid; u < (LDS_BYTES - LDS_MISC) / 4; u += NTHREADS) ((LAS unsigned*)(C.lds + LDS_MISC))[u] = 0u;
    __syncthreads();
    unsigned* ctl = (unsigned*)(CWS + WS_CTL);
    const int lo = args.ph_lo, hi = args.ph_hi;
    const bool one = (hi - lo) > 1;
    XcdBarrier bar; bar.bar = ctl + CW_BAR; bar.x = 0; bar.st = nullptr;
    if (one) bar = xcd_barrier_post(ctl + CW_BAR, (volatile LAS unsigned*)(C.lds + LDS_MISC), C.tid == 0);
#ifndef MK_EN
#define MK_EN 0xffff
#endif
#ifndef MK_DUP
#define MK_DUP 0
#endif
#define IN(k) (lo <= (k) && (k) < hi)
#define FRESH() do { unsigned z_; asm volatile("s_mov_b32 %0, 0" : "=s"(z_)); C.ws_ = (unsigned long long)args.ws + z_; C.out_ = (unsigned long long)args.out + z_; \
    C.wave = wave0 + (int)z_; C.bid = (int)blockIdx.x + (int)z_; C.G = (int)gridDim.x + (int)z_; C.gw = C.bid * NWAVES + C.wave; C.ngw = C.G * NWAVES; C.lane = fresh_lane(); C.tid = C.wave * 64 + C.lane; } while (0)
#define SEAM(k) do { if (IN(k) && IN((k) + 1)) { const int l_ = fresh_lane(); unsigned zb_; asm volatile("s_mov_b32 %0, 0" : "=s"(zb_)); XcdBarrier b2_ = bar; b2_.bar = bar.bar + zb_; b2_.x = bar.x + zb_; \
    xcd_barrier(b2_, wave0 + (int)zb_ == 0 && l_ == 0); } } while (0)
    LAS unsigned char* ring = C.lds;

    if ((MK_EN & 1) && IN(0)) { FRESH(); prologue(C); } SEAM(0);

    for (int l = 0; l < DEPTH; ++l) {
        const int p0 = 1 + l * PH_PER_LAYER;
        if ((MK_EN & 2) && IN(p0)) {
            FRESH();
            pg8::Gemm g{WSP(bf16_t, WS_X), WSP(bf16_t, WS_WIN) + (size_t)l * NIN * DM, T, NIN, DM}; pg8::StaticOrder S; S.init(T, NIN, C.G, C.bid);
            EpiIn E{CWS, COUT, l, CIN(10) + l * 256, CIN(11) + l * 256, (LAS float*)(C.lds + LDS_XCH)};
            pg8::gemm_phase<EpiIn, pg8::StaticOrder, true, true>(ring, g, S, E, C.wave);
            FRESH(); convert_caches(C, l);
        }
        SEAM(p0);
        if ((MK_EN & 4) && IN(p0 + 1)) {
            FRESH();
            if (MK_EN & 0x1000) { pg8::Gemm g{WSP(bf16_t, WS_CQN), WSP(bf16_t, WS_WUQ) + (size_t)l * 768 * 256, T, 768, 256}; pg8::StaticOrder S; S.init(T, 768, C.G, C.bid);
              EpiQup E{CWS};
              pg8::gemm_phase<EpiQup, pg8::StaticOrder, true, true>(ring, g, S, E, C.wave); }
            FRESH();
            if (MK_EN & 0x2000) { pg8::Gemm g{WSP(bf16_t, WS_CKVN), WSP(bf16_t, WS_WUKV) + (size_t)l * 1024 * 256, EC, 1024, 256}; pg8::StaticOrder S; S.init(EC, 1024, C.G, C.bid);
              EpiKVup E{CWS};
              pg8::gemm_phase<EpiKVup, pg8::StaticOrder, true, true>(ring, g, S, E, C.wave); }
#if (MK_DUP & 2)
            FRESH();
            { pg8::Gemm g{WSP(bf16_t, WS_CQN), WSP(bf16_t, WS_WUQ) + (size_t)l * 768 * 256, T, 768, 256}; pg8::StaticOrder S; S.init(T, 768, C.G, C.bid);
              EpiQup E{CWS};
              pg8::gemm_phase<EpiQup, pg8::StaticOrder, true, true>(ring, g, S, E, C.wave); }
            FRESH();
            { pg8::Gemm g{WSP(bf16_t, WS_CKVN), WSP(bf16_t, WS_WUKV) + (size_t)l * 1024 * 256, EC, 1024, 256}; pg8::StaticOrder S; S.init(EC, 1024, C.G, C.bid);
              EpiKVup E{CWS};
              pg8::gemm_phase<EpiKVup, pg8::StaticOrder, true, true>(ring, g, S, E, C.wave); }
#endif
        }
        SEAM(p0 + 1);
        if ((MK_EN & 8) && IN(p0 + 2)) { FRESH(); attn_phase(C, l, l);
#if (MK_DUP & 4)
            FRESH(); attn_phase(C, l, l + 4);
#endif
        }
        SEAM(p0 + 2);
        if ((MK_EN & 16) && IN(p0 + 3)) { FRESH(); norm_mixer(C, l); }
        SEAM(p0 + 3);
        if ((MK_EN & 32) && IN(p0 + 4)) {
            FRESH();
            pg8::Gemm g{WSP(bf16_t, WS_O), WSP(bf16_t, WS_WOUT) + (size_t)l * DM * DM, T, DM, DM}; pg8::StaticOrder S; S.init(T, DM, C.G, C.bid);
            EpiResid E{CWS, (unsigned)WS_SSQB};
            pg8::gemm_phase<EpiResid, pg8::StaticOrder, true, true>(ring, g, S, E, C.wave);
        }
        SEAM(p0 + 4);
        if ((MK_EN & 64) && IN(p0 + 5)) {
            FRESH();
            pg8::Gemm g{WSP(bf16_t, WS_X), WSP(bf16_t, WS_WUP) + (size_t)l * DFF * DM, T, DFF, DM}; pg8::StaticOrder S; S.init(T, DFF, C.G, C.bid);
            EpiFfnUp E{CWS};
            pg8::gemm_phase<EpiFfnUp, pg8::StaticOrder, true, true>(ring, g, S, E, C.wave);
#if (MK_DUP & 8)
            FRESH();
            { pg8::Gemm g2{WSP(bf16_t, WS_X), WSP(bf16_t, WS_WUP) + (size_t)l * DFF * DM, T, DFF, DM}; pg8::StaticOrder S2; S2.init(T, DFF, C.G, C.bid); EpiFfnUp E2{CWS};
              pg8::gemm_phase<EpiFfnUp, pg8::StaticOrder, true, true>(ring, g2, S2, E2, C.wave); }
#endif
        }
        SEAM(p0 + 5);
        if ((MK_EN & 128) && IN(p0 + 6)) {
            FRESH();
            pg8::Gemm g{WSP(bf16_t, WS_U), WSP(bf16_t, WS_WDN) + (size_t)l * DM * DFF, T, DM, DFF}; pg8::StaticOrder S; S.init(T, DM, C.G, C.bid);
            EpiResid E{CWS, (unsigned)WS_SSQA};
            pg8::gemm_phase<EpiResid, pg8::StaticOrder, true, true>(ring, g, S, E, C.wave);
        }
        SEAM(p0 + 6);
    }
    if ((MK_EN & 256) && IN(N_PHASES - 1)) { FRESH(); final_norm(C); }
#undef IN
#undef SEAM
}

#ifndef MK_SPLIT
#define MK_SPLIT 0
#endif
extern "C" void kernel_launch(void* const* d_in, const int* in_sizes, int n_in, void* d_out, int out_size, void* d_ws, size_t ws_size, hipStream_t stream) {
    static int grid = 0;
    if (grid == 0) {
        if (n_in != 23 || (long)out_size != OUT_TOTAL || ws_size < WS_END) { fprintf(stderr, "kernel_launch: unexpected shapes: n_in %d out %d ws %zu (need %zu)\n", n_in, out_size, ws_size, (size_t)WS_END); grid = -1; return; }
        int dev = 0, cus = 0;
        if (hipGetDevice(&dev) != hipSuccess || hipDeviceGetAttribute(&cus, hipDeviceAttributeMultiprocessorCount, dev) != hipSuccess) { grid = -1; return; }
        if (hipFuncSetAttribute((const void*)mk_fwd, hipFuncAttributeMaxDynamicSharedMemorySize, LDS_BYTES) != hipSuccess) { fprintf(stderr, "kernel_launch: hipFuncSetAttribute failed\n"); grid = -1; return; }
        int per_cu = 0;
        if (hipOccupancyMaxActiveBlocksPerMultiprocessor(&per_cu, (const void*)mk_fwd, NTHREADS, LDS_BYTES) != hipSuccess || per_cu < 1) fprintf(stderr, "kernel_launch: occupancy query reports %d\n", per_cu);
        (void)hipGetLastError();
        grid = cus;
    }
    if (grid < 0) return;
    if (hipMemsetAsync((char*)d_ws + WS_CTL, 0, CTL_BYTES, stream) != hipSuccess) return;
    Args a{};
    for (int i = 0; i < 23; ++i) a.in[i] = (const float*)d_in[i];
    a.out = (float*)d_out; a.ws = (unsigned char*)d_ws;
#if MK_SPLIT
    for (int p = 0; p < N_PHASES; ++p) { a.ph_lo = p; a.ph_hi = p + 1; hipLaunchKernelGGL(mk_fwd, dim3(grid), dim3(NTHREADS), LDS_BYTES, stream, a); }
#else
    a.ph_lo = 0; a.ph_hi = N_PHASES;
    hipLaunchKernelGGL(mk_fwd, dim3(grid), dim3(NTHREADS), LDS_BYTES, stream, a);
#endif
}
```
